# Optimizing an MI355X kernel written in HIP

```python
import math
import jax, jax.numpy as jnp
from jax import lax
import numpy as np

D_MODEL = 1024
BATCH = 16
SEQ = 4096
DEPTH = 2
DEC_BATCH = 2
DEC_SEQ = 8192
PAST_LEN = 128

A_HEADS = 8
A_DK = 128
A_DV = D_MODEL // A_HEADS
A_WK = A_HEADS * A_DK
A_WV = A_HEADS * A_DV
R_HEADS = 8
R_DK = 64
R_DV = 2 * R_DK
R_WK = R_HEADS * R_DK
R_WV = R_HEADS * R_DV
CHUNK = 64
ROPE_BASE = 10000.0
LN_EPS = 1e-5
LOG_FLOOR = 1e-30
NEG_BIG = -1e30
DEEPNORM_ALPHA = (2.0 * DEPTH) ** 0.25
DEEPNORM_BETA = (8.0 * DEPTH) ** -0.25
IN_SEGMENTS = [A_WK, A_WK, A_WK, A_WV, A_WV, R_WK, R_WK, R_WV, R_WV]
VALUE_SEGMENTS = (3, 7)
IN_WIDTH = sum(IN_SEGMENTS)
IN_OFFSETS = [int(v) for v in np.cumsum(IN_SEGMENTS)[:-1]]

kernel_name = 'hybrid_hgrn2_retention_encoder'

F32 = jnp.float32


def _flip(a):
    return jnp.flip(a, axis=1)


def _layer_norm(h):
    h = h.astype(F32)
    mu = jnp.mean(h, axis=-1, keepdims=True)
    var = jnp.mean(jnp.square(h - mu), axis=-1, keepdims=True)
    return (h - mu) * lax.rsqrt(var + LN_EPS)


def _rms_norm(o):
    return o * lax.rsqrt(jnp.mean(jnp.square(o), axis=-1, keepdims=True) + LN_EPS)


def _rope(T):
    pos = jnp.arange(T, dtype=F32)
    inv = ROPE_BASE ** (-jnp.arange(0, R_DK, 2, dtype=F32) / R_DK)
    ang = pos[:, None] * inv[None, :]
    return jnp.cos(ang)[:, None, :], jnp.sin(ang)[:, None, :]


def _apply_rope(x, cos, sin):
    x1, x2 = jnp.split(x, 2, axis=-1)
    return jnp.concatenate([x1 * cos - x2 * sin, x1 * sin + x2 * cos], axis=-1)


def _hgrn2_dir(q, k, logf, v):
    B_, T, H, dk = q.shape
    dv = v.shape[-1]
    N = T // CHUNK

    def chunks(a):
        return a.reshape(B_, N, CHUNK, H, a.shape[-1]).transpose(1, 0, 3, 2, 4)

    causal = jnp.tril(jnp.ones((CHUNK, CHUNK), dtype=bool))[:, :, None]

    def step(S, inp):
        qc, kc, fc, vc = inp
        b = jnp.cumsum(fc, axis=2)
        b_last = b[:, :, -1:, :]
        inter = jnp.einsum('bhtk,bhkv->bhtv', qc * jnp.exp(b), S)
        decay = jnp.exp(jnp.where(causal, b[:, :, :, None, :] - b[:, :, None, :, :], NEG_BIG))
        attn = jnp.einsum('bhtk,bhtsk,bhsk->bhts', qc, decay, kc)
        intra = jnp.einsum('bhts,bhsv->bhtv', attn, vc)
        S_new = jnp.exp(b_last[:, :, 0, :, None]) * S + jnp.einsum('bhsk,bhsv->bhkv', kc * jnp.exp(b_last - b), vc)
        return S_new, inter + intra

    S0 = jnp.zeros((B_, H, dk, dv), F32)
    _, o = lax.scan(step, S0, (chunks(q), chunks(k), chunks(logf), chunks(v)))
    return o.transpose(1, 0, 3, 2, 4).reshape(B_, T, H, dv)


def _retention_dir(q, k, v, lg):
    B_, T, H, dk = q.shape
    dv = v.shape[-1]
    N = T // CHUNK
    q = q.reshape(B_, N, CHUNK, H, dk)
    k = k.reshape(B_, N, CHUNK, H, dk)
    v = v.reshape(B_, N, CHUNK, H, dv)
    pos = jnp.arange(CHUNK, dtype=F32)
    dist = pos[:, None] - pos[None, :]
    decay = jnp.exp(jnp.where(dist[None] >= 0, dist[None] * lg[:, None, None], NEG_BIG))
    scores = jnp.einsum('bnthd,bnshd->bnhts', q, k) * decay
    intra = jnp.einsum('bnhts,bnshe->bnthe', scores, v)
    k_dec = k * jnp.exp((CHUNK - 1 - pos)[:, None] * lg[None, :])[:, :, None]
    kv = jnp.einsum('bnshd,bnshe->nbhde', k_dec, v)
    chunk_decay = jnp.exp(CHUNK * lg)[None, :, None, None]

    def step(S, kv_n):
        return S * chunk_decay + kv_n, S

    _, S_prev = lax.scan(step, jnp.zeros((B_, H, dk, dv), F32), kv)
    q_dec = q * jnp.exp((pos + 1)[:, None] * lg[None, :])[:, :, None]
    inter = jnp.einsum('bnthd,nbhde->bnthe', q_dec, S_prev)
    return (intra + inter).reshape(B_, T, H, dv)


def _layer(x, c, cos, sin, lb, w_ada, b_ada, w_in, a_norm_w, ret_decay, w_pa, w_pb, w_mg, b_mg, w_out, ln_g, ln_b):
    dt = x.dtype
    B_, T, _ = x.shape
    ada = jax.nn.silu(c) @ w_ada + b_ada
    shift, scale, gate = jnp.split(ada, 3, axis=-1)
    u = x * (1 + scale[:, None, :]) + shift[:, None, :]
    proj = u @ w_in
    aq, af_f, af_b, ai, ag, rq, rk, rv, rg = jnp.split(proj, IN_OFFSETS, axis=-1)

    q_a = (jax.nn.silu(aq.astype(F32)) * A_DK ** -0.5).reshape(B_, T, A_HEADS, A_DK)
    v_a = ai.astype(F32).reshape(B_, T, A_HEADS, A_DV)
    lbh = lb.reshape(A_HEADS, A_DK)
    log_lb = jnp.log(jnp.maximum(lbh, LOG_FLOOR))
    log_1m_lb = jnp.log1p(-lbh)

    def forget(fl):
        fl = fl.astype(F32).reshape(B_, T, A_HEADS, A_DK)
        logf = jnp.logaddexp(log_lb, log_1m_lb + jax.nn.log_sigmoid(fl))
        kk = (1.0 - lbh) * jax.nn.sigmoid(-fl)
        return logf, kk

    logf_f, k_f = forget(af_f)
    logf_b, k_b = forget(af_b)
    o_a = _hgrn2_dir(q_a, k_f, logf_f, v_a) + _flip(_hgrn2_dir(_flip(q_a), _flip(k_b), _flip(logf_b), _flip(v_a)))
    y_a = (_rms_norm(o_a) * a_norm_w).reshape(B_, T, A_WV) * jax.nn.silu(ag.astype(F32))
    y_a = y_a.astype(dt)

    q_r = _apply_rope(rq.astype(F32).reshape(B_, T, R_HEADS, R_DK), cos, sin) * R_DK ** -0.5
    k_r = _apply_rope(rk.astype(F32).reshape(B_, T, R_HEADS, R_DK), cos, sin)
    v_r = rv.astype(F32).reshape(B_, T, R_HEADS, R_DV)
    lg = jax.nn.log_sigmoid(ret_decay.astype(F32))
    o_r = _retention_dir(q_r, k_r, v_r, lg[0]) + _flip(_retention_dir(_flip(q_r), _flip(k_r), _flip(v_r), lg[1]))
    o_r = _layer_norm(o_r)
    y_r = (o_r.reshape(B_, T, R_WV) * jax.nn.silu(rg.astype(F32))).astype(dt)

    p_a = y_a @ w_pa
    p_r = y_r @ w_pb
    g_a, g_r = jnp.split(jax.nn.sigmoid(u @ w_mg + b_mg), 2, axis=-1)
    s = (g_a * p_a + g_r * p_r) @ w_out
    h = DEEPNORM_ALPHA * x + (1 + gate[:, None, :]) * s
    return (_layer_norm(h) * ln_g + ln_b).astype(dt)


def _trunk(x, c, lbs, w_ada, b_ada, w_in, a_norm_w, ret_decay, w_pa, w_pb, w_mg, b_mg, w_out, ln_g, ln_b):
    cos, sin = _rope(x.shape[1])
    for l in range(DEPTH):
        x = _layer(x, c, cos, sin, lbs[l], w_ada[l], b_ada[l], w_in[l], a_norm_w[l], ret_decay[l],
                   w_pa[l], w_pb[l], w_mg[l], b_mg[l], w_out[l], ln_g[l], ln_b[l])
    return x


def setup_inputs(seed: int = 0) -> dict:
    key = jax.random.key(seed)
    ks = jax.random.split(key, 24)

    def nrm(k, shape, s):
        return jax.random.normal(k, shape, F32) * s

    D = D_MODEL
    seg_keys = jax.random.split(ks[6], len(IN_SEGMENTS))
    w_in = jnp.concatenate([
        nrm(seg_keys[j], (DEPTH, D, w), D ** -0.5 * (DEEPNORM_BETA if j in VALUE_SEGMENTS else 1.0))
        for j, w in enumerate(IN_SEGMENTS)], axis=-1)
    eps = 2.0 ** -(5.0 + jnp.arange(R_HEADS, dtype=F32))
    decay_logit = jnp.log1p(-eps) - jnp.log(eps)
    return {
        'x_prompt': nrm(ks[0], (BATCH, SEQ, D), 1.0),
        'x_sample': nrm(ks[1], (DEC_BATCH, DEC_SEQ, D), 1.0),
        'c_prompt': nrm(ks[2], (BATCH, D), 1.0),
        'c_sample': nrm(ks[3], (DEC_BATCH, D), 1.0),
        'w_ada': nrm(ks[4], (DEPTH, D, 3 * D), 0.2 * D ** -0.5),
        'b_ada': nrm(ks[5], (DEPTH, 3 * D), 0.01),
        'w_in': w_in,
        'hgrn_lb': nrm(ks[7], (DEPTH, A_WK), 0.5),
        'a_norm_w': 1.0 + nrm(ks[8], (DEPTH, A_DV), 0.02),
        'ret_decay': decay_logit[None, None, :] + nrm(ks[9], (DEPTH, 2, R_HEADS), 0.01),
        'w_pa': nrm(ks[10], (DEPTH, A_WV, D), DEEPNORM_BETA * A_WV ** -0.5),
        'w_pb': nrm(ks[11], (DEPTH, R_WV, D), DEEPNORM_BETA * R_WV ** -0.5),
        'w_mg': nrm(ks[12], (DEPTH, D, 2 * D), D ** -0.5),
        'b_mg': nrm(ks[13], (DEPTH, 2 * D), 0.01),
        'w_out': nrm(ks[14], (DEPTH, D, D), DEEPNORM_BETA * D ** -0.5),
        'ln_g': 1.0 + nrm(ks[15], (DEPTH, D), 0.02),
        'ln_b': nrm(ks[16], (DEPTH, D), 0.01),
    }


def reference(x_prompt, x_sample, c_prompt, c_sample, w_ada, b_ada, w_in, hgrn_lb, a_norm_w, ret_decay,
              w_pa, w_pb, w_mg, b_mg, w_out, ln_g, ln_b):
    p = jax.nn.softmax(hgrn_lb.astype(F32), axis=0)
    lbs = jnp.cumsum(p, axis=0) - p[0:1]
    y_prompt = _trunk(x_prompt, c_prompt, lbs, w_ada, b_ada, w_in, a_norm_w, ret_decay,
                      w_pa, w_pb, w_mg, b_mg, w_out, ln_g, ln_b)
    y_sample = _trunk(x_sample, c_sample, lbs, w_ada, b_ada, w_in, a_norm_w, ret_decay,
                      w_pa, w_pb, w_mg, b_mg, w_out, ln_g, ln_b)
    return (y_prompt, y_sample)
```

```cpp
#include <hip/hip_runtime.h>
#include <hip/hip_cooperative_groups.h>
#include <cstdio>
#include <cmath>
namespace cg = cooperative_groups;

#define LAS __attribute__((address_space(3)))
typedef unsigned short bf16_t;
typedef short bf16x8 __attribute__((ext_vector_type(8)));
typedef float f32x4 __attribute__((ext_vector_type(4)));
typedef unsigned u32x4 __attribute__((ext_vector_type(4)));
typedef unsigned u32x2 __attribute__((ext_vector_type(2)));
typedef float f32x2 __attribute__((ext_vector_type(2)));

constexpr int D = 1024, NTOK = 81920, NPTOK = 65536, NSEQ = 18, MG = 40960, NC1 = 10240;
constexpr int C_AQ = 0, C_AFF = 1024, C_AFB = 2048, C_AI = 3072, C_AG = 4096, C_RQ = 5120, C_RK = 5632, C_RV = 6144, C_RG = 7168, C_MG = 8192;
constexpr float LN_EPS = 1e-5f;
constexpr float DN_ALPHA = 1.41421356237309515f;

constexpr size_t WS_BAR = 0;
constexpr size_t WS_WT1 = 16384;
constexpr size_t WS_WPA = WS_WT1 + (size_t)2 * 10240 * 1024 * 2;
constexpr size_t WS_WPB = WS_WPA + (size_t)2 * 1024 * 1024 * 2;
constexpr size_t WS_WOUT = WS_WPB + (size_t)2 * 1024 * 1024 * 2;
constexpr size_t WS_ADA = WS_WOUT + (size_t)2 * 1024 * 1024 * 2;
constexpr size_t WS_ROPE = WS_ADA + (size_t)2 * 18 * 3072 * 4;
constexpr size_t WS_U = WS_ROPE + (size_t)8192 * 32 * 8;
constexpr size_t WS_OB = WS_U + (size_t)MG * 1024 * 2;
constexpr size_t WS_PROJ = WS_OB + (size_t)MG * 1024 * 2;
constexpr size_t WS_END = WS_PROJ + (size_t)MG * NC1 * 2;

struct Params {
    const float* x_prompt; const float* x_sample; const float* c_prompt; const float* c_sample;
    const float* w_ada; const float* b_ada; const float* w_in; const float* hgrn_lb; const float* a_norm_w; const float* ret_decay;
    const float* w_pa; const float* w_pb; const float* w_mg; const float* b_mg; const float* w_out; const float* ln_g; const float* ln_b;
    float* out; unsigned char* ws;
    int ph_lo, ph_hi;
};

__device__ __forceinline__ int grow(int g, int r) { return g == 0 ? (r < 16384 ? 65536 + r : r - 16384) : 24576 + r; }
__device__ __forceinline__ int seq_of(int gr) { return gr < 65536 ? (gr >> 12) : 16 + ((gr - 65536) >> 13); }
__device__ __forceinline__ unsigned cvt_pk_bf16(float lo, float hi) { unsigned r; asm("v_cvt_pk_bf16_f32 %0, %1, %2" : "=v"(r) : "v"(lo), "v"(hi)); return r; }
__device__ __forceinline__ bf16_t f2bf(float f) { return (bf16_t)(cvt_pk_bf16(f, 0.f) & 0xffffu); }
__device__ __forceinline__ float bf_lo(unsigned u) { return __uint_as_float(u << 16); }
__device__ __forceinline__ float bf_hi(unsigned u) { return __uint_as_float(u & 0xffff0000u); }
__device__ __forceinline__ float bf2f(bf16_t b) { return __uint_as_float(((unsigned)b) << 16); }
__device__ __forceinline__ float rcp_(float x) { return __builtin_amdgcn_rcpf(x); }
__device__ __forceinline__ float exp2_(float x) { return __builtin_amdgcn_exp2f(x); }
__device__ __forceinline__ float sigmoidf_(float x) { return rcp_(1.0f + exp2_(-1.4426950408889634f * x)); }

namespace pg8 {
constexpr int BM = 256, BK = 64, HALF = 128, HTB = HALF * BK * 2  , STAGE_BYTES = 8 * HTB, NXCD = 8, WGM = 8;
__host__ __device__ __forceinline__ int lds_byte(int r, int c) { const int st = (r >> 4) * 2 + (c >> 5), rr = r & 15, cc = c & 31, ob = rr * 64 + cc * 2; return st * 1024 + (ob ^ (((ob >> 9) & 1) << 5)); }
__host__ __device__ __forceinline__ void stage_rc(int b, int& R, int& C) { const int st = b / 1024, sb = b % 1024, swz = sb ^ (((sb >> 9) & 1) << 5); R = (st >> 1) * 16 + swz / 64; C = (st & 1) * 32 + (swz % 64) / 2; }
__host__ __device__ __forceinline__ int perm32(int rho) { const int n = rho >> 4, i = rho & 15; return 8 * (i >> 2) + 4 * n + (i & 3); }

struct Unit { int pm, pn; };
struct Gemm { const bf16_t* A; const bf16_t* Bt; int M, N, K, lda, ldb; const bf16_t* A2; const bf16_t* Bt2; };

struct StaticOrder {
    int nM, nN, nwg, G, c, pm0;
    __host__ __device__ void init(int M, int N, int G_, int c_, int pm0_ = 0) { nM = M / BM; nN = N / BM; nwg = nM * nN; G = G_; c = c_; pm0 = pm0_; }
    __host__ __device__ bool next(int i, Unit& u) const {
        const long L = (long)i * G + c; if (L >= nwg) return false;
        int wgid = (int)L; { const int q = nwg / NXCD, r = nwg % NXCD, xcd = wgid % NXCD, off = wgid / NXCD; wgid = (xcd < r ? xcd * (q + 1) : r * (q + 1) + (xcd - r) * q) + off; }
        const int nig = WGM * nN, gid = wgid / nig, fm = gid * WGM, gsz = (nM - fm) < WGM ? (nM - fm) : WGM;
        u.pm = pm0 + fm + ((wgid % nig) % gsz); u.pn = (wgid % nig) / gsz; return true;
    }
};

template <class Epi>
__device__ __forceinline__ void gemm_phase(LAS unsigned char* lds, const Gemm g, const StaticOrder& S, const Epi& E) {
    int tid_ = threadIdx.x; asm volatile("" : "+v"(tid_));
    const int tid = tid_, wid = __builtin_amdgcn_readfirstlane(tid >> 6), lane = tid & 63, wr = wid >> 2, wc = wid & 3, fr = lane & 15, fq = lane >> 4;
    const int K = g.K, nt = K / BK, npass = g.A2 ? 2 : 1;
    unsigned voffA[2], voffB[2];
#pragma unroll
    for (int i = 0; i < 2; ++i) { int R, C; stage_rc(tid * 16 + i * 8192, R, C); const int Rb = Epi::PERM ? ((R & ~31) + perm32(R & 31)) : R;
        voffA[i] = (unsigned)(R * g.lda + C) * 2u; voffB[i] = (unsigned)(Rb * g.ldb + C) * 2u; }
    const size_t kstep = (size_t)(BK * 2);
    const size_t hstepA = (size_t)HALF * g.lda * 2, hstepB = (size_t)HALF * g.ldb * 2;
    const size_t tstepA = 2 * hstepA, tstepB = 2 * hstepB;
    const unsigned ldsw = (unsigned)wid * 1024u;
    const int aoff = lds_byte(wr * 64 + fr, fq * 8), boff = lds_byte(wc * 32 + fr, fq * 8);
#define PG8_SA(b, h) (((b) * 2 + (h)) * HTB)
#define PG8_SB(b, h) ((4 + (b) * 2 + (h)) * HTB)
#define PG8_STAGE(bufoff, gbase, voff) do { _Pragma("unroll") for (int _i = 0; _i < 2; ++_i) \
        __builtin_amdgcn_global_load_lds((const unsigned*)((const char*)(gbase) + (voff)[_i]), (LAS unsigned*)(lds + (bufoff) + ldsw + _i * 8192), 16, 0, 0); } while (0)
#define PG8_LDA(dst, b, h) do { _Pragma("unroll") for (int m = 0; m < 4; ++m) _Pragma("unroll") for (int k = 0; k < 2; ++k) dst[m][k] = *(const LAS bf16x8*)(lds + PG8_SA(b, h) + aoff + m * 2048 + k * 1024); } while (0)
#define PG8_LDB(dst, b, h) do { _Pragma("unroll") for (int n = 0; n < 2; ++n) _Pragma("unroll") for (int k = 0; k < 2; ++k) dst[n][k] = *(const LAS bf16x8*)(lds + PG8_SB(b, h) + boff + n * 2048 + k * 1024); } while (0)
#define PG8_MMA(ai, bj, At, Bt) do { __builtin_amdgcn_s_setprio(1); _Pragma("unroll") for (int m = 0; m < 4; ++m) _Pragma("unroll") for (int n = 0; n < 2; ++n) _Pragma("unroll") for (int k = 0; k < 2; ++k) \
        acc[ai][bj][m][n] = __builtin_amdgcn_mfma_f32_16x16x32_bf16(Bt[n][k], At[m][k], acc[ai][bj][m][n], 0, 0, 0); __builtin_amdgcn_s_setprio(0); } while (0)
#define PG8_WAIT_V(n) asm volatile("s_waitcnt vmcnt(" #n ")" ::: "memory")
#define PG8_WAIT_L(n) asm volatile("s_waitcnt lgkmcnt(" #n ")" ::: "memory")
#define PG8_BAR __builtin_amdgcn_s_barrier()
#define PG8_SCHED __builtin_amdgcn_sched_barrier(0)
    Unit cur, nxt; int ui = 0;
    if (!S.next(0, cur)) return;
    f32x4 acc[2][2][4][2];
#pragma unroll
    for (int a = 0; a < 2; ++a)
#pragma unroll
        for (int b = 0; b < 2; ++b)
#pragma unroll
            for (int m = 0; m < 4; ++m)
#pragma unroll
                for (int n = 0; n < 2; ++n) acc[a][b][m][n] = (f32x4){0.f, 0.f, 0.f, 0.f};
    bf16x8 At[4][2], B0[2][2], B1[2][2];
    const char* cA = (const char*)g.A + (size_t)cur.pm * tstepA; const char* cB = (const char*)g.Bt + (size_t)cur.pn * tstepB;
    PG8_STAGE(PG8_SB(0, 0), cB, voffB); PG8_STAGE(PG8_SA(0, 0), cA, voffA); PG8_STAGE(PG8_SB(0, 1), cB + hstepB, voffB); PG8_STAGE(PG8_SA(0, 1), cA + hstepA, voffA);
    if (wr == 1) PG8_BAR;
    PG8_WAIT_V(4); PG8_BAR;
    PG8_STAGE(PG8_SB(1, 0), cB + kstep, voffB); PG8_STAGE(PG8_SA(1, 0), cA + kstep, voffA); PG8_STAGE(PG8_SB(1, 1), cB + hstepB + kstep, voffB);
    PG8_WAIT_V(6); PG8_BAR;
    for (;;) {
        const bool has_next = S.next(ui + 1, nxt);
        const char* nA = cA; const char* nB = cB;
        for (int pass = 0; pass < npass; ++pass) {
        const bool lastpass = (pass == npass - 1);
        if (!lastpass) { nA = (const char*)g.A2 + (size_t)cur.pm * tstepA; nB = (const char*)g.Bt2 + (size_t)cur.pn * tstepB; }
        else if (has_next) { nA = (const char*)g.A + (size_t)nxt.pm * tstepA; nB = (const char*)g.Bt + (size_t)nxt.pn * tstepB; }
        else { nA = cA; nB = cB; }
        for (int t = 0; t < nt; t += 2) {
            const bool last = (t == nt - 2);
            const char* a1 = cA + (size_t)(t + 1) * kstep;
            const char* a2 = last ? nA : cA + (size_t)(t + 2) * kstep; const char* b2 = last ? nB : cB + (size_t)(t + 2) * kstep;
            const char* a3 = a2 + kstep; const char* b3 = b2 + kstep;
            PG8_LDB(B0, 0, 0); PG8_SCHED; PG8_LDA(At, 0, 0); PG8_STAGE(PG8_SA(1, 1), a1 + hstepA, voffA);
            PG8_WAIT_L(8); PG8_BAR; PG8_WAIT_L(0); PG8_MMA(0, 0, At, B0); PG8_BAR; PG8_SCHED;
            PG8_LDB(B1, 0, 1); PG8_STAGE(PG8_SB(0, 0), b2, voffB);
            PG8_BAR; PG8_WAIT_L(0); PG8_MMA(0, 1, At, B1); PG8_BAR;
            PG8_LDA(At, 0, 1); PG8_STAGE(PG8_SA(0, 0), a2, voffA);
            PG8_BAR; PG8_WAIT_L(0); PG8_MMA(1, 0, At, B0); PG8_BAR; PG8_SCHED;
            PG8_STAGE(PG8_SB(0, 1), b2 + hstepB, voffB);
            PG8_WAIT_V(6); PG8_BAR; PG8_MMA(1, 1, At, B1); PG8_BAR;
            PG8_LDB(B0, 1, 0); PG8_SCHED; PG8_LDA(At, 1, 0); PG8_STAGE(PG8_SA(0, 1), a2 + hstepA, voffA);
            PG8_WAIT_L(8); PG8_BAR; PG8_WAIT_L(0); PG8_MMA(0, 0, At, B0); PG8_BAR; PG8_SCHED;
            PG8_LDB(B1, 1, 1); PG8_STAGE(PG8_SB(1, 0), b3, voffB);
            PG8_BAR; PG8_WAIT_L(0); PG8_MMA(0, 1, At, B1); PG8_BAR;
            PG8_LDA(At, 1, 1); PG8_STAGE(PG8_SA(1, 0), a3, voffA);
            PG8_BAR; PG8_WAIT_L(0); PG8_MMA(1, 0, At, B0); PG8_BAR; PG8_SCHED;
            PG8_STAGE(PG8_SB(1, 1), b3 + hstepB, voffB);
            PG8_WAIT_V(6); PG8_BAR; PG8_MMA(1, 1, At, B1); PG8_BAR;
        }
        if (!lastpass) { E.mid(acc, cur, wr, wc, fr, fq); cA = nA; cB = nB; }
        }
        E(acc, cur, wr, wc, fr, fq);
        if (!has_next) break;
#pragma unroll
        for (int a = 0; a < 2; ++a)
#pragma unroll
            for (int b = 0; b < 2; ++b)
#pragma unroll
                for (int m = 0; m < 4; ++m)
#pragma unroll
                    for (int n = 0; n < 2; ++n) acc[a][b][m][n] = (f32x4){0.f, 0.f, 0.f, 0.f};
        cur = nxt; cA = nA; cB = nB; ++ui;
    }
    PG8_WAIT_V(0);
    if (wr == 0) PG8_BAR;
    PG8_BAR;
#undef PG8_SA
#undef PG8_SB
#undef PG8_STAGE
#undef PG8_LDA
#undef PG8_LDB
#undef PG8_MMA
#undef PG8_WAIT_V
#undef PG8_WAIT_L
#undef PG8_BAR
#undef PG8_SCHED
}
}

#define XB_TMO      128
#define XB_XCNT(j)  (256  + 64 * (j))
#define XB_XSUB(j)  (1280 + 64 * (j))
#define XB_XGEN(j)  (2304 + 64 * (j))
#define XB_TOP      3328
#define XB_TOPGEN   3392
#define XCD_BAR_WORDS 3456
#define XB_SPIN_CAP (1u << 18)

__device__ __forceinline__ unsigned xb_ld(unsigned* p)              { return __hip_atomic_load(p, __ATOMIC_RELAXED, __HIP_MEMORY_SCOPE_AGENT); }
__device__ __forceinline__ unsigned xb_add(unsigned* p, unsigned v) { return __hip_atomic_fetch_add(p, v, __ATOMIC_RELAXED, __HIP_MEMORY_SCOPE_AGENT); }
__device__ __forceinline__ unsigned xb_xcc_id() { return (unsigned)__builtin_amdgcn_s_getreg((3 << 11) | 20) & 0xFu; }
#define XB_SPIN(cond, bar) do { unsigned _sp = 0; while (cond) { __builtin_amdgcn_s_sleep(1); \
    if ((++_sp & 255u) == 0u) { if (xb_ld(&(bar)[XB_TMO])) break; if (_sp > XB_SPIN_CAP) { atomicAdd(&(bar)[XB_TMO], 1u); break; } } } } while (0)

struct XcdBarrier {
    unsigned* bar; unsigned x;
    volatile LAS unsigned* st;
};

__device__ __forceinline__ XcdBarrier xcd_barrier_post(unsigned* bar, volatile LAS unsigned* st) {
    XcdBarrier b; b.bar = bar; b.x = xb_xcc_id(); b.st = st;
    if (threadIdx.x == 0) (void)xb_add(&bar[XB_XCNT(b.x)], 1u);
    return b;
}
__device__ __forceinline__ void xcd_barrier_complete(unsigned* bar, unsigned x, unsigned& nloc, unsigned& nx) {
    const unsigned G = gridDim.x * gridDim.y * gridDim.z;
    unsigned sum, cnt, mine, sp = 0u;
    for (;;) {
        sum = 0u; cnt = 0u; mine = 0u;
#pragma unroll
        for (unsigned j = 0; j < 16; ++j) { const unsigned c = xb_ld(&bar[XB_XCNT(j)]); sum += c; cnt += (c > 0u) ? 1u : 0u; mine = (j == x) ? c : mine; }
        if (sum == G) break;
        __builtin_amdgcn_s_sleep(1);
        if ((++sp & 255u) == 0u) { if (xb_ld(&bar[XB_TMO])) break; if (sp > XB_SPIN_CAP) { atomicAdd(&bar[XB_TMO], 1u); break; } }
    }
    nloc = mine > 0u ? mine : 1u; nx = cnt > 0u ? cnt : 1u;
}

__device__ __forceinline__ void xcd_barrier(const XcdBarrier& b) {
    asm volatile("s_waitcnt vmcnt(0)" ::: "memory");
    __syncthreads();
    if (threadIdx.x == 0) {
        unsigned* bar = b.bar;
        __builtin_amdgcn_s_waitcnt(0);
        unsigned nloc = b.st[0], nx = b.st[1];
        if (nloc == 0u) { xcd_barrier_complete(bar, b.x, nloc, nx); b.st[0] = nloc; b.st[1] = nx; }
        const unsigned old = xb_add(&bar[XB_XSUB(b.x)], 1u);
        const unsigned gen = old / nloc;
        if (old + 1u == (gen + 1u) * nloc) {
            __builtin_amdgcn_fence(__ATOMIC_RELEASE, "agent");
            asm volatile("s_waitcnt vmcnt(0)" ::: "memory");
            const unsigned og = xb_add(&bar[XB_TOP], 1u);
            const unsigned tg = og / nx;
            if (og + 1u == (tg + 1u) * nx) xb_add(&bar[XB_TOPGEN], 1u);
            else XB_SPIN(xb_ld(&bar[XB_TOPGEN]) == tg, bar);
            __builtin_amdgcn_fence(__ATOMIC_ACQUIRE, "agent");
            xb_add(&bar[XB_XGEN(b.x)], 1u);
            asm volatile("s_waitcnt vmcnt(0)" ::: "memory");
        } else {
            XB_SPIN(xb_ld(&bar[XB_XGEN(b.x)]) == gen, bar);
            __builtin_amdgcn_fence(__ATOMIC_ACQUIRE, "agent");
            asm volatile("s_waitcnt vmcnt(0)" ::: "memory");
        }
    }
    __syncthreads();
}


__device__ __forceinline__ void subset_barrier(unsigned* ctr, unsigned target) {
    asm volatile("s_waitcnt vmcnt(0)" ::: "memory");
    __syncthreads();
    if (threadIdx.x == 0) {
        __builtin_amdgcn_fence(__ATOMIC_RELEASE, "agent");
        asm volatile("s_waitcnt vmcnt(0)" ::: "memory");
        (void)xb_add(ctr, 1u);
        unsigned sp = 0u;
        while (xb_ld(ctr) < target) { __builtin_amdgcn_s_sleep(2); if (++sp > (1u << 22)) break; }
        __builtin_amdgcn_fence(__ATOMIC_ACQUIRE, "agent");
        asm volatile("s_waitcnt vmcnt(0)" ::: "memory");
    }
    __syncthreads();
}

__device__ __forceinline__ int rope_pos(int g, int row) { const int gr = grow(g, row); return gr < NPTOK ? (gr & 4095) : ((gr - NPTOK) & 8191); }
struct EpiAll {
    static constexpr bool PERM = true;
    int mode;
    bf16_t* O; const bf16_t* proj; const float* bias;
    const float* xp; const float* xs; float* out; int g, layer;
    const float* lbp; const float2* rope;
    __device__ __forceinline__ void mid(f32x4 (&acc)[2][2][4][2], const pg8::Unit& u, int wr, int wc, int fr_in, int fq_in) const {
        int fr = fr_in, fq = fq_in; asm volatile("" : "+v"(fr), "+v"(fq));
        const int row0 = u.pm * 256 + wr * 64 + fr, col0 = u.pn * 256 + wc * 32 + 8 * fq;
#pragma unroll
        for (int i = 0; i < 16; ++i) { const int ai = i >> 3, m = (i >> 1) & 3, bj = i & 1; const int n = col0 + bj * 128;
            const u32x4 gq = *(const u32x4*)(proj + (size_t)(row0 + ai * 128 + m * 16) * NC1 + C_MG + (n >> 7) * 256 + (n & 127));
            acc[ai][bj][m][0][0] *= bf_lo(gq.x); acc[ai][bj][m][0][1] *= bf_hi(gq.x); acc[ai][bj][m][0][2] *= bf_lo(gq.y); acc[ai][bj][m][0][3] *= bf_hi(gq.y);
            acc[ai][bj][m][1][0] *= bf_lo(gq.z); acc[ai][bj][m][1][1] *= bf_hi(gq.z); acc[ai][bj][m][1][2] *= bf_lo(gq.w); acc[ai][bj][m][1][3] *= bf_hi(gq.w); }
    }
    __device__ __forceinline__ void operator()(const f32x4 (&acc)[2][2][4][2], const pg8::Unit& u, int wr, int wc, int fr_in, int fq_in) const {
        int fr = fr_in, fq = fq_in; asm volatile("" : "+v"(fr), "+v"(fq));
        const int row0 = u.pm * 256 + wr * 64 + fr, col0 = u.pn * 256 + wc * 32 + 8 * fq;
        if (mode == 0) {
            const int pn = u.pn;
            const int kind = (pn < 4) ? 1 : (pn < 12) ? 2 : (pn < 20) ? 0 : (pn < 24) ? 4 : (pn < 32) ? 0 : 5;
            f32x4 den[2][4][2];
#pragma unroll
            for (int bj = 0; bj < 2; ++bj) {
                const int col = col0 + bj * 128;
                f32x4 b0 = (f32x4){0.f, 0.f, 0.f, 0.f}, b1 = b0, c0 = (f32x4){1.f, 1.f, 1.f, 1.f}, c1 = c0;
                if (kind == 5) { const int nb = (pn - 32) * 128 + wc * 32 + 8 * fq + bj * 1024; b0 = *(const f32x4*)(bias + nb); b1 = *(const f32x4*)(bias + nb + 4); }
                if (kind == 2) {
                    if (layer == 1) { const int ch = col & 1023;
                        const f32x4 a0 = *(const f32x4*)(lbp + ch), a1 = *(const f32x4*)(lbp + ch + 4), d0 = *(const f32x4*)(lbp + 1024 + ch), d1 = *(const f32x4*)(lbp + 1024 + ch + 4);
#pragma unroll
                        for (int j = 0; j < 4; ++j) { const float l0 = sigmoidf_(d0[j] - a0[j]), l1 = sigmoidf_(d1[j] - a1[j]);
                            b0[j] = fmaxf(l0, 1e-30f); b1[j] = fmaxf(l1, 1e-30f); c0[j] = 1.0f - l0; c1[j] = 1.0f - l1; } }
                    else { b0 = (f32x4){1e-30f, 1e-30f, 1e-30f, 1e-30f}; b1 = b0; } }
                f32x4 rr0[4], rr1[4];
#define ROPE_PTR(idx) ((const f32x4*)(rope + (size_t)rope_pos(g, row0 + (((idx) >> 2) & 1) * 128 + ((idx) & 3) * 16) * 32 + ((col & 63) >> 1)))
                if (kind == 4) {
#pragma unroll
                    for (int k = 0; k < 4; ++k) { const f32x4* rp = ROPE_PTR(k); rr0[k] = rp[0]; rr1[k] = rp[1]; } }
#pragma unroll
                for (int ai = 0; ai < 2; ++ai)
#pragma unroll
                    for (int m = 0; m < 4; ++m) { f32x4 v0 = acc[ai][bj][m][0], v1 = acc[ai][bj][m][1];
                        const int row = row0 + ai * 128 + m * 16;
                        if (kind == 1) {
#pragma unroll
                            for (int j = 0; j < 4; ++j) { v0[j] = v0[j] * sigmoidf_(v0[j]) * 0.08838834764831845f; v1[j] = v1[j] * sigmoidf_(v1[j]) * 0.08838834764831845f; }
                        } else if (kind == 2) {
#pragma unroll
                            for (int j = 0; j < 4; ++j) { const float x0 = fminf(fmaxf(v0[j], -60.f), 60.f), x1 = fminf(fmaxf(v1[j], -60.f), 60.f);
                                if (layer == 0) {
                                    v0[j] = -__builtin_amdgcn_logf(1.0f + exp2_(-1.4426950408889634f * x0)); v1[j] = -__builtin_amdgcn_logf(1.0f + exp2_(-1.4426950408889634f * x1)); }
                                else { v0[j] = __builtin_amdgcn_logf(b0[j] + c0[j] * sigmoidf_(x0)); v1[j] = __builtin_amdgcn_logf(b1[j] + c1[j] * sigmoidf_(x1)); } }
                        } else if (kind == 3) {
#pragma unroll
                            for (int j = 0; j < 4; ++j) { v0[j] = v0[j] * sigmoidf_(v0[j]); v1[j] = v1[j] * sigmoidf_(v1[j]); }
                        } else if (kind == 4) {
                            const int idx = ai * 4 + m;
                            const f32x4 r0 = rr0[idx & 3], r1 = rr1[idx & 3]; const float qs = (pn < 22) ? 0.125f : 1.0f;
                            if (idx + 4 < 8) { const f32x4* rp = ROPE_PTR(idx + 4); rr0[idx & 3] = rp[0]; rr1[idx & 3] = rp[1]; }
                            f32x4 w0, w1;
                            w0[0] = (v0[0] * r0[0] - v0[1] * r0[1]) * qs; w0[1] = (v0[0] * r0[1] + v0[1] * r0[0]) * qs; w0[2] = (v0[2] * r0[2] - v0[3] * r0[3]) * qs; w0[3] = (v0[2] * r0[3] + v0[3] * r0[2]) * qs;
                            w1[0] = (v1[0] * r1[0] - v1[1] * r1[1]) * qs; w1[1] = (v1[0] * r1[1] + v1[1] * r1[0]) * qs; w1[2] = (v1[2] * r1[2] - v1[3] * r1[3]) * qs; w1[3] = (v1[2] * r1[3] + v1[3] * r1[2]) * qs;
                            v0 = w0; v1 = w1;
                        } else if (kind == 5) {
                            v0 += b0; v1 += b1;
#pragma unroll
                            for (int j = 0; j < 4; ++j) { v0[j] = 1.0f + exp2_(-1.4426950408889634f * v0[j]); v1[j] = 1.0f + exp2_(-1.4426950408889634f * v1[j]); }
                            if (bj == 0) { den[ai][m][0] = v0; den[ai][m][1] = v1; continue; }
                            f32x4 s0, s1, q0, q1;
#pragma unroll
                            for (int j = 0; j < 4; ++j) { s0[j] = rcp_(v0[j]); s1[j] = rcp_(v1[j]); q0[j] = v0[j] * rcp_(den[ai][m][0][j]); q1[j] = v1[j] * rcp_(den[ai][m][1][j]); }
                            u32x4 wq; wq.x = cvt_pk_bf16(q0[0], q0[1]); wq.y = cvt_pk_bf16(q0[2], q0[3]); wq.z = cvt_pk_bf16(q1[0], q1[1]); wq.w = cvt_pk_bf16(q1[2], q1[3]);
                            *(u32x4*)(O + (size_t)row * NC1 + col - 128) = wq;
                            v0 = s0; v1 = s1; }
                        u32x4 w; w.x = cvt_pk_bf16(v0[0], v0[1]); w.y = cvt_pk_bf16(v0[2], v0[3]); w.z = cvt_pk_bf16(v1[0], v1[1]); w.w = cvt_pk_bf16(v1[2], v1[3]);
                        *(u32x4*)(O + (size_t)row * NC1 + col) = w;
                        } }
        } else if (mode == 3) {
            const int gr0 = grow(g, u.pm * 256), s = seq_of(gr0);
            const float* xb = layer ? (const float*)out + (size_t)gr0 * 1024 : (gr0 < NPTOK ? xp + (size_t)gr0 * 1024 : xs + (size_t)(gr0 - NPTOK) * 1024);
            float* ob = out + (size_t)gr0 * 1024;
            const int rl0 = wr * 64 + fr;
            f32x4 gv[2][2];
#pragma unroll
            for (int bj = 0; bj < 2; ++bj) { gv[bj][0] = *(const f32x4*)(bias + s * 3072 + 2048 + col0 + bj * 128) + 1.0f; gv[bj][1] = *(const f32x4*)(bias + s * 3072 + 2048 + col0 + bj * 128 + 4) + 1.0f; }
            f32x4 xr[4][2];
#define E3_OFF(i) ((size_t)(rl0 + ((i) >> 3) * 128 + (((i) >> 1) & 3) * 16) * 1024 + col0 + ((i) & 1) * 128)
#pragma unroll
            for (int k = 0; k < 4; ++k) { xr[k][0] = *(const f32x4*)(xb + E3_OFF(k)); xr[k][1] = *(const f32x4*)(xb + E3_OFF(k) + 4); }
#pragma unroll
            for (int i = 0; i < 16; ++i) {
                const f32x4 x0 = xr[i & 3][0], x1 = xr[i & 3][1];
                if (i + 4 < 16) { xr[i & 3][0] = *(const f32x4*)(xb + E3_OFF(i + 4)); xr[i & 3][1] = *(const f32x4*)(xb + E3_OFF(i + 4) + 4); }
                const int ai = i >> 3, m = (i >> 1) & 3, bj = i & 1;
                *(f32x4*)(ob + E3_OFF(i)) = x0 * DN_ALPHA + gv[bj][0] * acc[ai][bj][m][0]; *(f32x4*)(ob + E3_OFF(i) + 4) = x1 * DN_ALPHA + gv[bj][1] * acc[ai][bj][m][1];
            }
#undef E3_OFF
        } else {
            u32x4 gr[4];
#define E2_ROW(i) ((size_t)(row0 + ((i) >> 3) * 128 + (((i) >> 1) & 3) * 16))
#define E2_COL(i) (col0 + ((i) & 1) * 128)
#define E2_G(i) (C_MG + (E2_COL(i) >> 7) * 256 + 128 + (E2_COL(i) & 127))
#pragma unroll
            for (int k = 0; k < 4; ++k) gr[k] = *(const u32x4*)(proj + E2_ROW(k) * NC1 + E2_G(k));
#pragma unroll
            for (int i = 0; i < 16; ++i) {
                const u32x4 ga = gr[i & 3];
                if (i + 4 < 16) gr[i & 3] = *(const u32x4*)(proj + E2_ROW(i + 4) * NC1 + E2_G(i + 4));
                const int ai = i >> 3, m = (i >> 1) & 3, bj = i & 1;
                f32x4 v0 = acc[ai][bj][m][0], v1 = acc[ai][bj][m][1];
                v0[0] *= bf_lo(ga.x); v0[1] *= bf_hi(ga.x); v0[2] *= bf_lo(ga.y); v0[3] *= bf_hi(ga.y);
                v1[0] *= bf_lo(ga.z); v1[1] *= bf_hi(ga.z); v1[2] *= bf_lo(ga.w); v1[3] *= bf_hi(ga.w);
                u32x4 w; w.x = cvt_pk_bf16(v0[0], v0[1]); w.y = cvt_pk_bf16(v0[2], v0[3]); w.z = cvt_pk_bf16(v1[0], v1[1]); w.w = cvt_pk_bf16(v1[2], v1[3]);
                *(u32x4*)(O + E2_ROW(i) * 1024 + E2_COL(i)) = w;
            }
#undef E2_ROW
#undef E2_COL
#undef E2_G
        }
    }
};

__device__ __forceinline__ void phase_init(const Params& p, LAS unsigned char* lds) {
    int tid_ = threadIdx.x; asm volatile("" : "+v"(tid_));
    const int tid = tid_, nb = gridDim.x, b = blockIdx.x;
    LAS float* tile = (LAS float*)lds;
    for (int u = b; u < 2 * 208 * 16; u += nb) {
        const int l = u / (208 * 16), rem = u % (208 * 16), ntile = rem >> 4, kt = rem & 15;
        const float* src; int ldsrc, ncol0; bf16_t* dst;
        if (ntile < 128)      { src = p.w_in + (size_t)l * 1024 * 8192; ldsrc = 8192; ncol0 = ntile * 64;         dst = (bf16_t*)(p.ws + WS_WT1) + ((size_t)l * 10240 + ncol0) * 1024; }
        else if (ntile < 160) { src = p.w_mg + (size_t)l * 1024 * 2048; ldsrc = 2048; ncol0 = (ntile - 128) * 64; dst = (bf16_t*)(p.ws + WS_WT1) + ((size_t)l * 10240 + 8192 + ncol0) * 1024; }
        else if (ntile < 176) { src = p.w_pa + (size_t)l * 1024 * 1024; ldsrc = 1024; ncol0 = (ntile - 160) * 64; dst = (bf16_t*)(p.ws + WS_WPA) + ((size_t)l * 1024 + ncol0) * 1024; }
        else if (ntile < 192) { src = p.w_pb + (size_t)l * 1024 * 1024; ldsrc = 1024; ncol0 = (ntile - 176) * 64; dst = (bf16_t*)(p.ws + WS_WPB) + ((size_t)l * 1024 + ncol0) * 1024; }
        else                  { src = p.w_out + (size_t)l * 1024 * 1024; ldsrc = 1024; ncol0 = (ntile - 192) * 64; dst = (bf16_t*)(p.ws + WS_WOUT) + ((size_t)l * 1024 + ncol0) * 1024; }
        const int k0 = kt * 64;
        { const int kr = tid >> 3, c8 = (tid & 7) * 8; const float* s = src + (size_t)(k0 + kr) * ldsrc + ncol0 + c8;
          const f32x4 a = *(const f32x4*)s, c = *(const f32x4*)(s + 4);
#pragma unroll
          for (int j = 0; j < 4; ++j) { tile[kr * 65 + c8 + j] = a[j]; tile[kr * 65 + c8 + 4 + j] = c[j]; } }
        __syncthreads();
        { const int n = tid >> 3, kg = (tid & 7) * 8; float v[8];
#pragma unroll
          for (int j = 0; j < 8; ++j) v[j] = tile[(kg + j) * 65 + n];
          u32x4 w; w.x = cvt_pk_bf16(v[0], v[1]); w.y = cvt_pk_bf16(v[2], v[3]); w.z = cvt_pk_bf16(v[4], v[5]); w.w = cvt_pk_bf16(v[6], v[7]);
          int np = n;
          if (ntile >= 80 && ntile < 96) np = ((n & 31) << 1) | (n >> 5);
          if (ntile >= 128 && ntile < 160) { const int L = (ntile - 128) * 64 + n, which = L >> 10, nn = L & 1023; np = (nn >> 7) * 256 + which * 128 + (nn & 127) - (ntile - 128) * 64; }
          *(u32x4*)(dst + (ptrdiff_t)np * 1024 + k0 + kg) = w; }
        __syncthreads();
    }
    float* adap = (float*)(p.ws + WS_PROJ);
    for (int u = b; u < 96; u += nb) {
        const int cb = u % 6, ks = (u / 6) % 8, l = u / 48;
        __syncthreads();
        for (int e = tid; e < 18 * 128; e += 512) { const int s = e >> 7, k = e & 127;
            const float c = (s < 16) ? p.c_prompt[s * 1024 + ks * 128 + k] : p.c_sample[(s - 16) * 1024 + ks * 128 + k];
            tile[e] = c / (1.0f + __expf(-c)); }
        __syncthreads();
        const int n = cb * 512 + tid; float acc[18];
#pragma unroll
        for (int s = 0; s < 18; ++s) acc[s] = 0.f;
        const float* w = p.w_ada + (size_t)l * 1024 * 3072 + (size_t)(ks * 128) * 3072 + n;
#pragma unroll 4
        for (int k = 0; k < 128; ++k) { const float wv = w[(size_t)k * 3072];
#pragma unroll
            for (int s = 0; s < 18; ++s) acc[s] += tile[s * 128 + k] * wv; }
#pragma unroll
        for (int s = 0; s < 18; ++s) adap[(size_t)((ks * 2 + l) * 18 + s) * 3072 + n] = acc[s];
    }
    float2* rope = (float2*)(p.ws + WS_ROPE);
    for (int e = b * 512 + tid; e < 8192 * 32; e += nb * 512) {
        const int pos = e >> 5, i = e & 31;
        double inv = 1.0; for (int k = 0; k < i; ++k) inv *= 0.7498942093324559;
        const double rev = (double)pos * inv * 0.15915494309189533577;
        double fr = rev - floor(rev); if (fr > 0.5) fr -= 1.0;
        const double r = fr * 6.28318530717958647692, r2 = r * r;
        double s = 1.0, c = 1.0;
#pragma unroll
        for (int n = 13; n >= 1; --n) { s = 1.0 - s * r2 * (1.0 / (double)((2 * n) * (2 * n + 1))); c = 1.0 - c * r2 * (1.0 / (double)((2 * n - 1) * (2 * n))); }
        rope[e] = make_float2((float)c, (float)(s * r));
    }
}

__device__ __forceinline__ void phase_ada_fin(const Params& p) {
    const float* adap = (const float*)(p.ws + WS_PROJ); float* ada = (float*)(p.ws + WS_ADA);
    int tid_ = threadIdx.x; asm volatile("" : "+v"(tid_));
    for (int e = blockIdx.x * 512 + tid_; e < 2 * 18 * 3072; e += gridDim.x * 512) {
        const int l = e / (18 * 3072), n = e % 3072; float a = p.b_ada[l * 3072 + n];
#pragma unroll
        for (int ks = 0; ks < 8; ++ks) a += adap[(size_t)ks * 110592 + e];
        ada[e] = a;
    }
}

__device__ __forceinline__ void phase_prep(const Params& p, int l, int g) {
    int tid_ = threadIdx.x; asm volatile("" : "+v"(tid_));
    const int tid = tid_; const float* ada = (const float*)(p.ws + WS_ADA) + l * 18 * 3072;
    unsigned* U32 = (unsigned*)(p.ws + WS_U);
    for (int strip = blockIdx.x; strip < MG / 16; strip += gridDim.x) {
        const int r0 = strip * 16, gr0 = grow(g, r0), s = seq_of(gr0);
        const float* src = l ? (const float*)p.out + (size_t)gr0 * 1024 : (gr0 < NPTOK ? p.x_prompt + (size_t)gr0 * 1024 : p.x_sample + (size_t)(gr0 - NPTOK) * 1024);
        const float2 sh = *(const float2*)(ada + s * 3072 + 2 * tid), sc = *(const float2*)(ada + s * 3072 + 1024 + 2 * tid);
#pragma unroll 8
        for (int i = 0; i < 16; ++i) { const float2 x = *(const float2*)(src + (size_t)i * 1024 + 2 * tid);
            U32[(size_t)(r0 + i) * 512 + tid] = cvt_pk_bf16(x.x * (1.0f + sc.x) + sh.x, x.y * (1.0f + sc.y) + sh.y); }
    }
}

__device__ __forceinline__ void ln_row(float* row, const f32x4 (&vin)[4], const float* gam, const float* bet, int lane, const float* ada_next, unsigned* urow) {
    f32x4 v[4]; float s = 0.f;
#pragma unroll
    for (int i = 0; i < 4; ++i) { v[i] = vin[i]; s += (v[i][0] + v[i][1]) + (v[i][2] + v[i][3]); }
#pragma unroll
    for (int o = 32; o >= 1; o >>= 1) s += __shfl_xor(s, o);
    const float mu = s * (1.0f / 1024.0f); float q = 0.f;
#pragma unroll
    for (int i = 0; i < 4; ++i) { v[i] -= mu; q += (v[i][0] * v[i][0] + v[i][1] * v[i][1]) + (v[i][2] * v[i][2] + v[i][3] * v[i][3]); }
#pragma unroll
    for (int o = 32; o >= 1; o >>= 1) q += __shfl_xor(q, o);
    const float rstd = 1.0f / sqrtf(q * (1.0f / 1024.0f) + LN_EPS);
#pragma unroll
    for (int i = 0; i < 4; ++i) { const f32x4 gm = *(const f32x4*)(gam + i * 256 + lane * 4), bt = *(const f32x4*)(bet + i * 256 + lane * 4);
        const f32x4 y = v[i] * rstd * gm + bt; *(f32x4*)(row + i * 256 + lane * 4) = y;
        if (ada_next) { const f32x4 sh = *(const f32x4*)(ada_next + i * 256 + lane * 4), sc = *(const f32x4*)(ada_next + 1024 + i * 256 + lane * 4); const f32x4 uu = y * (sc + 1.0f) + sh;
            u32x2 pk; pk.x = cvt_pk_bf16(uu[0], uu[1]); pk.y = cvt_pk_bf16(uu[2], uu[3]); *(u32x2*)(urow + i * 128 + lane * 2) = pk; } }
}
__device__ __forceinline__ void phase_ln(const Params& p, int l, int g, bool emit_u) {
    int tid_ = threadIdx.x; asm volatile("" : "+v"(tid_));
    const int lane = tid_ & 63, wv = tid_ >> 6;
    const float* gam = p.ln_g + l * 1024; const float* bet = p.ln_b + l * 1024;
    const int stride = gridDim.x * 8;
    for (int r = blockIdx.x * 8 + wv; r < MG; r += 4 * stride) {
        float* rows[4]; f32x4 v[4][4];
#pragma unroll
        for (int k = 0; k < 4; ++k) { const int rr = r + k * stride; rows[k] = p.out + (size_t)grow(g, rr < MG ? rr : r) * 1024;
#pragma unroll
            for (int i = 0; i < 4; ++i) v[k][i] = __builtin_nontemporal_load((const f32x4*)(rows[k] + i * 256 + lane * 4)); }
#pragma unroll
        for (int k = 0; k < 4; ++k) if (r + k * stride < MG) { const int rr = r + k * stride; const int sq = seq_of(grow(g, rr));
            ln_row(rows[k], v[k], gam, bet, lane, emit_u ? (const float*)(p.ws + WS_ADA) + (l + 1) * 18 * 3072 + sq * 3072 : nullptr, (unsigned*)(p.ws + WS_U) + (size_t)rr * 512); }
    }
}

struct CombIn { u32x4 a, b, g; };
__device__ __forceinline__ void comb_ptrs(const Params& p, int u, int sub, const bf16_t*& pf, const bf16_t*& pb, bf16_t*& pg) {
    bf16_t* proj = (bf16_t*)(p.ws + WS_PROJ); const bf16_t* of_r = (const bf16_t*)(p.ws + WS_U); const bf16_t* ob_r = (const bf16_t*)(p.ws + WS_OB);
    const int r = u >> 4, mh = u & 15; const bool isA = mh < 8; const int h = mh & 7;
    pf = isA ? proj + (size_t)r * NC1 + C_AFF + h * 128 + sub * 8 : of_r + (size_t)r * 1024 + h * 128 + sub * 8;
    pb = isA ? proj + (size_t)r * NC1 + C_AFB + h * 128 + sub * 8 : ob_r + (size_t)r * 1024 + h * 128 + sub * 8;
    pg = proj + (size_t)r * NC1 + (isA ? C_AG : C_RG) + h * 128 + sub * 8;
}
__device__ __forceinline__ void comb_unit(const CombIn& in, bool isA, const f32x4& nw0, const f32x4& nw1, bf16_t* pg) {
    const u32x4 a = in.a, bq = in.b, gq = in.g;
    float o[8], gt[8];
    o[0] = bf_lo(a.x) + bf_lo(bq.x); o[1] = bf_hi(a.x) + bf_hi(bq.x); o[2] = bf_lo(a.y) + bf_lo(bq.y); o[3] = bf_hi(a.y) + bf_hi(bq.y);
    o[4] = bf_lo(a.z) + bf_lo(bq.z); o[5] = bf_hi(a.z) + bf_hi(bq.z); o[6] = bf_lo(a.w) + bf_lo(bq.w); o[7] = bf_hi(a.w) + bf_hi(bq.w);
    gt[0] = bf_lo(gq.x); gt[1] = bf_hi(gq.x); gt[2] = bf_lo(gq.y); gt[3] = bf_hi(gq.y); gt[4] = bf_lo(gq.z); gt[5] = bf_hi(gq.z); gt[6] = bf_lo(gq.w); gt[7] = bf_hi(gq.w);
    if (!isA) { float s = 0.f;
#pragma unroll
        for (int j = 0; j < 8; ++j) s += o[j];
        s += __shfl_xor(s, 1); s += __shfl_xor(s, 2); s += __shfl_xor(s, 4); s += __shfl_xor(s, 8);
        const float mu = s * (1.0f / 128.0f);
#pragma unroll
        for (int j = 0; j < 8; ++j) o[j] -= mu; }
    float q = 0.f;
#pragma unroll
    for (int j = 0; j < 8; ++j) q += o[j] * o[j];
    q += __shfl_xor(q, 1); q += __shfl_xor(q, 2); q += __shfl_xor(q, 4); q += __shfl_xor(q, 8);
    const float rs = 1.0f / sqrtf(q * (1.0f / 128.0f) + LN_EPS);
    float y[8];
#pragma unroll
    for (int j = 0; j < 8; ++j) { const float wn = isA ? (j < 4 ? nw0[j & 3] : nw1[j & 3]) : 1.0f; y[j] = o[j] * rs * wn * gt[j] * sigmoidf_(gt[j]); }
    u32x4 w; w.x = cvt_pk_bf16(y[0], y[1]); w.y = cvt_pk_bf16(y[2], y[3]); w.z = cvt_pk_bf16(y[4], y[5]); w.w = cvt_pk_bf16(y[6], y[7]);
    *(u32x4*)pg = w;
}
__device__ __forceinline__ void phase_comb(const Params& p, int l, int row_lo, int nrows, int nb, int bi) {
    int tid_ = threadIdx.x; asm volatile("" : "+v"(tid_));
    const int tid = tid_, sub = tid & 15;
    const f32x4 nw0 = *(const f32x4*)(p.a_norm_w + l * 128 + sub * 8), nw1 = *(const f32x4*)(p.a_norm_w + l * 128 + sub * 8 + 4);
    const int ngrp = nb * 32, total = (row_lo + nrows) * 16;
    for (int u = row_lo * 16 + ((bi * 512 + tid) >> 4); u < total; u += 4 * ngrp) {
        CombIn in[4]; bf16_t* pg[4];
#pragma unroll
        for (int k = 0; k < 4; ++k) { const int uu = (u + k * ngrp < total) ? u + k * ngrp : u; const bf16_t* pf; const bf16_t* pb; comb_ptrs(p, uu, sub, pf, pb, pg[k]);
            in[k].a = __builtin_nontemporal_load((const u32x4*)pf); in[k].b = __builtin_nontemporal_load((const u32x4*)pb); in[k].g = __builtin_nontemporal_load((const u32x4*)pg[k]); }
#pragma unroll
        for (int k = 0; k < 4; ++k) if (u + k * ngrp < total) comb_unit(in[k], (u & 15) < 8, nw0, nw1, pg[k]);
    }
}

__device__ __forceinline__ bf16x8 ldfrag(const LAS unsigned char* base, int pitch, int tile, int ks, int fr, int fq) {
    return *(const LAS bf16x8*)(base + (tile * 16 + fr) * pitch + (ks * 32 + fq * 8) * 2);
}
#define LDS_BARRIER() do { asm volatile("s_waitcnt lgkmcnt(0)" ::: "memory"); __builtin_amdgcn_s_barrier(); asm volatile("" ::: "memory"); } while (0)
#define MFMA16(a, b, c) __builtin_amdgcn_mfma_f32_16x16x32_bf16((a), (b), (c), 0, 0, 0)

constexpr int MIX_LDS_MAX = 139264;
template <int DK, bool IS_A, int NDV>
__device__ __forceinline__ void mix_stream(const Params& p, LAS unsigned char* lds, int l, int rs, int T, int h, int dir, int dvh) {
    constexpr int QP = (DK + 8) * 2, TP = 144, KS = DK / 32;
    static_assert(NDV == 8, "tile ownership below is written for all 128 value channels");
    constexpr int DVW = IS_A ? 4 : 2;
    constexpr int NTV = 2 * DVW, NO = NDV / 2;
    constexpr int OFF_Q = 0, OFF_K = OFF_Q + 64 * QP, OFF_VT = OFF_K + 64 * QP, OFF_KT = OFF_VT + 128 * TP, OFF_ST = OFF_KT + DK * TP, OFF_P = OFF_ST + 128 * QP,
                  OFF_SEG = OFF_P + 64 * TP, OFF_CDEC = OFF_SEG + 8 * DK * 4, OFF_CSC = OFF_CDEC + DK * 4, OFF_O = OFF_CSC + DK * 4, OP = 272;
    static_assert(OFF_O + 64 * OP <= MIX_LDS_MAX, "mixer LDS");
    int tid_ = threadIdx.x; asm volatile("" : "+v"(tid_));
    const int tid = tid_, lane = tid & 63, w = __builtin_amdgcn_readfirstlane(tid >> 6), fr = lane & 15, fq = lane >> 4, cp = lane, sg = w;
    const int gx = ((fr + 4) >> 3) & 1, fqx = fq ^ gx, gk = ((((2 * cp) & 15) + 4) >> 3) & 1, sgx = (sg & 1) << 4;
    LAS unsigned char* Qs = lds + OFF_Q; LAS unsigned char* Ks = lds + OFF_K; LAS unsigned char* Vt = lds + OFF_VT; LAS unsigned char* Kt = lds + OFF_KT;
    LAS unsigned char* St = lds + OFF_ST; LAS unsigned char* Ps = lds + OFF_P; LAS unsigned char* Os = lds + OFF_O;
    LAS float* seg = (LAS float*)(lds + OFF_SEG); LAS float* cdec = (LAS float*)(lds + OFF_CDEC); LAS float* csc = (LAS float*)(lds + OFF_CSC);
    const bf16_t* proj = (const bf16_t*)(p.ws + WS_PROJ);
    const int N = T >> 6;
    const int cq = IS_A ? (C_AQ + h * 128) : (C_RQ + h * 64);
    const int cf = IS_A ? ((dir ? C_AFB : C_AFF) + h * 128) : (C_RK + h * 64);
    const int cv = (IS_A ? (C_AI + h * 128) : (C_RV + h * 128)) + dvh * 64;
    bf16_t* obase; int opitch, ocol;
    if (IS_A) { obase = (bf16_t*)(p.ws + WS_PROJ); opitch = NC1; ocol = (dir ? C_AFB : C_AFF) + h * 128 + dvh * 64; }
    else { obase = (bf16_t*)(p.ws + (dir ? WS_OB : WS_U)); opitch = 1024; ocol = h * 128 + dvh * 64; }
    float lg = 0.f;
    if (!IS_A) { const float x = p.ret_decay[l * 16 + dir * 8 + h]; lg = -log1pf(expf(-x)); }
    const int tdk0 = IS_A ? 2 * (w & 3) : 2 * (w & 1), tdv0 = IS_A ? (w >> 2) * 4 : (w >> 1) * 2;

    f32x4 S[NTV], U[NTV];
#pragma unroll
    for (int i = 0; i < NTV; ++i) { S[i] = (f32x4){0.f, 0.f, 0.f, 0.f}; U[i] = (f32x4){0.f, 0.f, 0.f, 0.f}; }
    unsigned rq[2][8], rv[2][8], rf[2][8];
    unsigned vo[8];
#pragma unroll
    for (int i = 0; i < 8; ++i) { const int t = sg * 8 + i; vo[i] = (unsigned)((dir ? 63 - t : t) * (NC1 * 2)); }
    const unsigned cqk_b = IS_A ? (unsigned)(cq * 2 + 4 * cp) : (unsigned)((cp < 32 ? cq : cf) * 2 + 4 * (cp & 31));
    const unsigned cf_b = (unsigned)(cf * 2 + 4 * cp), cv_b = (unsigned)(cv * 2 + 4 * cp);
#define MIX_RB(nn) (rs + (dir ? T - 64 - (nn) * 64 : (nn) * 64))
#define MIX_LOAD(nn, pp) do { const char* cb = (const char*)proj + (size_t)MIX_RB(nn) * (NC1 * 2); \
        _Pragma("unroll") for (int i = 0; i < 8; ++i) { \
        rq[pp][i] = *(const unsigned*)(cb + (vo[i] + cqk_b)); \
        if (IS_A) rf[pp][i] = *(const unsigned*)(cb + (vo[i] + cf_b)); \
        if (NDV == 8 || cp < 32) rv[pp][i] = *(const unsigned*)(cb + (vo[i] + cv_b)); } } while (0)
    const unsigned fo = (unsigned)((dir ? 63 - (tid >> 3) : (tid >> 3)) * opitch * 2 + (ocol + (tid & 7) * (NDV == 8 ? 16 : 8)) * 2);
#define MIX_FLUSH(nn) do { char* ob_ = (char*)obase + (size_t)MIX_RB(nn) * (opitch * 2) + fo; \
        if (NDV == 8) { const LAS unsigned char* src = Os + (tid >> 3) * OP + (tid & 7) * 32; \
            const u32x4 v0 = *(const LAS u32x4*)src, v1 = *(const LAS u32x4*)(src + 16); *(u32x4*)ob_ = v0; *(u32x4*)(ob_ + 16) = v1; } \
        else { const LAS unsigned char* src = Os + (tid >> 3) * OP + (tid & 7) * 16; const u32x4 v0 = *(const LAS u32x4*)src; *(u32x4*)ob_ = v0; } } while (0)
    MIX_LOAD(0, 0);
    for (int n = 0; n < N; ++n) { constexpr int par = 0;
        if (IS_A) {
            float run0 = 0.f, run1 = 0.f;
#pragma unroll
            for (int i = 0; i < 8; ++i) { run0 += bf_lo(rf[par][i]); run1 += bf_hi(rf[par][i]); }
            *(LAS f32x2*)(seg + sg * DK + 2 * cp) = (f32x2){run0, run1};
        }
        LDS_BARRIER();
        if (n > 0) MIX_FLUSH(n - 1);
        {
            unsigned kt0[4], kt1[4], vt0[4], vt1[4];
            if (IS_A) {
                float pre0 = 0.f, pre1 = 0.f, ref0 = 0.f, ref1 = 0.f, tot0 = 0.f, tot1 = 0.f;
#pragma unroll
                for (int s8 = 0; s8 < 8; ++s8) { const f32x2 v = *(const LAS f32x2*)(seg + s8 * DK + 2 * cp);
                    if (s8 < sg) { pre0 += v.x; pre1 += v.y; } if (s8 < 4) { ref0 += v.x; ref1 += v.y; } tot0 += v.x; tot1 += v.y; }
                f32x2 E = (f32x2){exp2_(fminf(fmaxf(pre0 - ref0, -115.f), 115.f)), exp2_(fminf(fmaxf(pre1 - ref1, -115.f), 115.f))};
#pragma unroll
                for (int ip = 0; ip < 4; ++ip) { unsigned kp[2];
#pragma unroll
                    for (int e = 0; e < 2; ++e) { const int i = 2 * ip + e;
                        const f32x2 f = (f32x2){exp2_(bf_lo(rf[par][i])), exp2_(bf_hi(rf[par][i]))};
                        E = __builtin_elementwise_max(E * f, (f32x2){1e-35f, 1e-35f});
                        const f32x2 r = (f32x2){rcp_(E.x), rcp_(E.y)};
                        const f32x2 k = r - f * r;
                        const f32x2 qv = (f32x2){bf_lo(rq[par][i]), bf_hi(rq[par][i])} * E;
                        const int t = sg * 8 + i;
                        const int cb4 = (4 * cp) ^ ((i >= 4 ? 16 : 0) ^ sgx);
                        *(LAS unsigned*)(Qs + t * QP + cb4) = cvt_pk_bf16(qv.x, qv.y);
                        kp[e] = cvt_pk_bf16(k.x, k.y);
                        *(LAS unsigned*)(Ks + t * QP + cb4) = kp[e]; }
                    kt0[ip] = __builtin_amdgcn_perm(kp[1], kp[0], 0x05040100u); kt1[ip] = __builtin_amdgcn_perm(kp[1], kp[0], 0x07060302u);
                    vt0[ip] = __builtin_amdgcn_perm(rv[par][2 * ip + 1], rv[par][2 * ip], 0x05040100u); vt1[ip] = __builtin_amdgcn_perm(rv[par][2 * ip + 1], rv[par][2 * ip], 0x07060302u);
                }
                if (sg == 0) { *(LAS f32x2*)(cdec + 2 * cp) = (f32x2){exp2_(fmaxf(tot0, -115.f)), exp2_(fmaxf(tot1, -115.f))};
                               *(LAS f32x2*)(csc + 2 * cp) = (f32x2){exp2_(fmaxf(tot0 - ref0, -115.f)), exp2_(fmaxf(tot1 - ref1, -115.f))}; }
                *(LAS u32x4*)(Kt + (2 * cp) * TP + ((sg * 16) ^ (gk << 4))) = (u32x4){kt0[0], kt0[1], kt0[2], kt0[3]};
                *(LAS u32x4*)(Kt + (2 * cp + 1) * TP + ((sg * 16) ^ (gk << 4))) = (u32x4){kt1[0], kt1[1], kt1[2], kt1[3]};
            } else {
                const int ci = cp & 31;
#pragma unroll
                for (int ip = 0; ip < 4; ++ip) { unsigned kp[2];
#pragma unroll
                    for (int e = 0; e < 2; ++e) { const int i = 2 * ip + e; const int t = sg * 8 + i;
                        const float dd = (float)(t - 31) * lg;
                        const float sc = __expf(cp < 32 ? dd : -dd);
                        kp[e] = cvt_pk_bf16(bf_lo(rq[par][i]) * sc, bf_hi(rq[par][i]) * sc);
                        *(LAS unsigned*)((cp < 32 ? Qs : Ks) + t * QP + ((4 * ci) ^ ((i >= 4 ? 16 : 0) ^ sgx))) = kp[e]; }
                    kt0[ip] = __builtin_amdgcn_perm(kp[1], kp[0], 0x05040100u); kt1[ip] = __builtin_amdgcn_perm(kp[1], kp[0], 0x07060302u);
                    vt0[ip] = __builtin_amdgcn_perm(rv[par][2 * ip + 1], rv[par][2 * ip], 0x05040100u); vt1[ip] = __builtin_amdgcn_perm(rv[par][2 * ip + 1], rv[par][2 * ip], 0x07060302u);
                }
                if (cp >= 32) { *(LAS u32x4*)(Kt + (2 * ci) * TP + ((sg * 16) ^ (gk << 4))) = (u32x4){kt0[0], kt0[1], kt0[2], kt0[3]};
                                *(LAS u32x4*)(Kt + (2 * ci + 1) * TP + ((sg * 16) ^ (gk << 4))) = (u32x4){kt1[0], kt1[1], kt1[2], kt1[3]}; }
            }
            if (NDV == 8 || cp < 32) {
            *(LAS u32x4*)(Vt + (2 * cp) * TP + ((sg * 16) ^ (gk << 4))) = (u32x4){vt0[0], vt0[1], vt0[2], vt0[3]};
            *(LAS u32x4*)(Vt + (2 * cp + 1) * TP + ((sg * 16) ^ (gk << 4))) = (u32x4){vt1[0], vt1[1], vt1[2], vt1[3]}; }
        }
#pragma unroll
        for (int dki = 0; dki < 2; ++dki) { f32x4 er;
          if (IS_A) { const int dk = (tdk0 + dki) * 16 + fq * 4; const f32x4 e = *(const LAS f32x4*)(seg + dk) + *(const LAS f32x4*)(seg + DK + dk) + *(const LAS f32x4*)(seg + 2 * DK + dk) + *(const LAS f32x4*)(seg + 3 * DK + dk);
#pragma unroll
              for (int j = 0; j < 4; ++j) er[j] = exp2_(fmaxf(e[j], -115.f)); }
          else { const float e = __expf(32.0f * lg); er = (f32x4){e, e, e, e}; }
#pragma unroll
          for (int dvi = 0; dvi < DVW; ++dvi) { const f32x4 sv = S[dki * DVW + dvi] * er; u32x2 pk; pk.x = cvt_pk_bf16(sv[0], sv[1]); pk.y = cvt_pk_bf16(sv[2], sv[3]);
              *(LAS u32x2*)(St + ((tdv0 + dvi) * 16 + fr) * QP + ((((tdk0 + dki) * 16 + fq * 4) * 2) ^ (gx << 4))) = pk; } }
        if (n + 1 < N) MIX_LOAD(n + 1, par);
        LDS_BARRIER();
        { const int tt = w >> 1, ts0 = (w & 1) * 2; f32x4 pa = (f32x4){0.f, 0.f, 0.f, 0.f}, pb = pa;
          bf16x8 gq_[KS], gk0[KS], gk1[KS];
#pragma unroll
          for (int ks = 0; ks < KS; ++ks) { gq_[ks] = ldfrag(Qs, QP, tt, ks, fr, fqx); gk0[ks] = ldfrag(Ks, QP, ts0, ks, fr, fqx); gk1[ks] = ldfrag(Ks, QP, ts0 + 1, ks, fr, fqx); }
          __builtin_amdgcn_sched_barrier(0);
#pragma unroll
          for (int ks = 0; ks < KS; ++ks) { pa = MFMA16(gk0[ks], gq_[ks], pa); pb = MFMA16(gk1[ks], gq_[ks], pb); }
          const int t = tt * 16 + fr, s0 = ts0 * 16 + fq * 4, s1 = s0 + 16;
          u32x2 w0, w1;
          w0.x = cvt_pk_bf16(t >= s0 ? pa[0] : 0.f, t >= s0 + 1 ? pa[1] : 0.f); w0.y = cvt_pk_bf16(t >= s0 + 2 ? pa[2] : 0.f, t >= s0 + 3 ? pa[3] : 0.f);
          w1.x = cvt_pk_bf16(t >= s1 ? pb[0] : 0.f, t >= s1 + 1 ? pb[1] : 0.f); w1.y = cvt_pk_bf16(t >= s1 + 2 ? pb[2] : 0.f, t >= s1 + 3 ? pb[3] : 0.f);
          *(LAS u32x2*)(Ps + t * TP + ((s0 * 2) ^ (gx << 4))) = w0; *(LAS u32x2*)(Ps + t * TP + ((s1 * 2) ^ (gx << 4))) = w1; }
#pragma unroll
        for (int ks = 0; ks < 2; ++ks) { bf16x8 ak[2], bv[DVW];
#pragma unroll
            for (int dki = 0; dki < 2; ++dki) ak[dki] = ldfrag(Kt, TP, tdk0 + dki, ks, fr, fqx);
#pragma unroll
            for (int dvi = 0; dvi < DVW; ++dvi) bv[dvi] = ldfrag(Vt, TP, tdv0 + dvi, ks, fr, fqx);
            __builtin_amdgcn_sched_barrier(0);
#pragma unroll
            for (int dki = 0; dki < 2; ++dki)
#pragma unroll
                for (int dvi = 0; dvi < DVW; ++dvi) U[dki * DVW + dvi] = MFMA16(ak[dki], bv[dvi], U[dki * DVW + dvi]);
            __builtin_amdgcn_sched_barrier(0); }
        LDS_BARRIER();
        { const int tp = w >> 2, dp = w & 3; f32x4 o[4];
#pragma unroll
          for (int q = 0; q < 4; ++q) o[q] = (f32x4){0.f, 0.f, 0.f, 0.f};
#pragma unroll
          for (int kb = 0; kb < KS; kb += 2) { bf16x8 b[2][2], a[2][2];
#pragma unroll
              for (int k2 = 0; k2 < 2; ++k2)
#pragma unroll
                  for (int i2 = 0; i2 < 2; ++i2) { b[k2][i2] = ldfrag(Qs, QP, 2 * tp + i2, kb + k2, fr, fqx); a[k2][i2] = ldfrag(St, QP, 2 * dp + i2, kb + k2, fr, fqx); }
              __builtin_amdgcn_sched_barrier(0);
#pragma unroll
              for (int k2 = 0; k2 < 2; ++k2)
#pragma unroll
                  for (int ti = 0; ti < 2; ++ti)
#pragma unroll
                      for (int di = 0; di < 2; ++di) o[ti * 2 + di] = MFMA16(a[k2][di], b[k2][ti], o[ti * 2 + di]);
              __builtin_amdgcn_sched_barrier(0); }
          { bf16x8 b[2][2], a[2][2];
#pragma unroll
              for (int k2 = 0; k2 < 2; ++k2)
#pragma unroll
                  for (int i2 = 0; i2 < 2; ++i2) { b[k2][i2] = ldfrag(Ps, TP, 2 * tp + i2, k2, fr, fqx); a[k2][i2] = ldfrag(Vt, TP, 2 * dp + i2, k2, fr, fqx); }
              __builtin_amdgcn_sched_barrier(0);
#pragma unroll
              for (int k2 = 0; k2 < 2; ++k2)
#pragma unroll
                  for (int ti = 0; ti < 2; ++ti)
#pragma unroll
                      for (int di = 0; di < 2; ++di) o[ti * 2 + di] = MFMA16(a[k2][di], b[k2][ti], o[ti * 2 + di]);
              __builtin_amdgcn_sched_barrier(0); }
#pragma unroll
          for (int ti = 0; ti < 2; ++ti)
#pragma unroll
              for (int di = 0; di < 2; ++di) { const f32x4 ov = o[ti * 2 + di]; u32x2 pk; pk.x = cvt_pk_bf16(ov[0], ov[1]); pk.y = cvt_pk_bf16(ov[2], ov[3]);
                  *(LAS u32x2*)(Os + ((2 * tp + ti) * 16 + fr) * OP + ((2 * dp + di) * 16 + fq * 4) * 2) = pk; } }
#pragma unroll
        for (int dki = 0; dki < 2; ++dki) { f32x4 cd, cs;
          if (IS_A) { cd = *(const LAS f32x4*)(cdec + (tdk0 + dki) * 16 + fq * 4); cs = *(const LAS f32x4*)(csc + (tdk0 + dki) * 16 + fq * 4); }
          else { const float a = __expf(64.0f * lg), b = __expf(32.0f * lg); cd = (f32x4){a, a, a, a}; cs = (f32x4){b, b, b, b}; }
#pragma unroll
          for (int dvi = 0; dvi < DVW; ++dvi) { S[dki * DVW + dvi] = S[dki * DVW + dvi] * cd + U[dki * DVW + dvi] * cs; U[dki * DVW + dvi] = (f32x4){0.f, 0.f, 0.f, 0.f}; } }
    }
    __syncthreads();
    MIX_FLUSH(N - 1);
    __syncthreads();
#undef MIX_LOAD
#undef MIX_FLUSH
#undef MIX_RB
}

__device__ __forceinline__ void phase_mix(const Params& p, LAS unsigned char* lds, int l, int g) {
    const int G = gridDim.x, b = blockIdx.x;
    const int nstreams = g == 0 ? 256 : 320;
    for (int r = 0; r * G < nstreams; ++r) {
        const int bi = (r & 1) ? (G - 1 - b) : b; const int sidx = r * G + bi;
        if (sidx >= nstreams) continue;
        bool isA; int q, rs, T;
        if (g == 0) {
            if (sidx < 64) { isA = sidx < 32; q = sidx & 31; rs = (q >> 4) * 8192; T = 8192; }
            else { isA = sidx < 160; q = isA ? sidx - 64 : sidx - 160; rs = 16384 + (q >> 4) * 4096; T = 4096; }
        } else { isA = sidx < 160; q = isA ? sidx : sidx - 160; rs = (q >> 4) * 4096; T = 4096; }
        const int h = (q >> 1) & 7, dir = q & 1;
        if (isA) mix_stream<128, true, 8>(p, lds, l, rs, T, h, dir, 0); else mix_stream<64, false, 8>(p, lds, l, rs, T, h, dir, 0);
    }
}

constexpr int N_PHASES = 3 + 6 * 4;
constexpr int LDS_BYTES = MIX_LDS_MAX + 16;

__global__ void __launch_bounds__(512, 2) fwd_megakernel(Params p) {
    extern __shared__ __attribute__((aligned(16))) unsigned char lds_raw[];
    LAS unsigned char* lds = (LAS unsigned char*)lds_raw;
    cg::grid_group grid = cg::this_grid();
    if (threadIdx.x < 4) ((LAS unsigned*)(lds + MIX_LDS_MAX))[threadIdx.x] = 0u;
    __syncthreads();
    XcdBarrier xbar = xcd_barrier_post((unsigned*)(p.ws + WS_BAR), (volatile LAS unsigned*)(lds + MIX_LDS_MAX));
    const int G = gridDim.x, bid = blockIdx.x;
    bf16_t* proj = (bf16_t*)(p.ws + WS_PROJ); bf16_t* ubuf = (bf16_t*)(p.ws + WS_U);
    for (int ph = p.ph_lo; ph < p.ph_hi; ++ph) {
        if (ph == 0) phase_init(p, lds);
        else if (ph == 1) phase_ada_fin(p);
        else if (ph == 2) phase_prep(p, 0, 0);
        else {
            const int idx = (ph - 3) / 6, sub = (ph - 3) % 6, g = idx >> 1, l = idx & 1;
            const bool ovl = (G == 256) && (g == 0);
            bool extra = false;
            if (sub == 1) {
                phase_mix(p, lds, l, g);
                if (ovl && bid >= 64) {
                    unsigned* sb = (unsigned*)(p.ws + WS_BAR) + 3520 + l * 128;
                    subset_barrier(sb, 192u);
                    phase_comb(p, l, 16384, MG - 16384, 192, bid - 64);
                    subset_barrier(sb + 64, 192u);
                    extra = true;
                }
            }
            else if (sub == 2) { if (ovl) phase_comb(p, l, 0, 16384, G, bid); else phase_comb(p, l, 0, MG, G, bid); }
            if (sub == 0 || sub == 3 || sub == 4 || extra) {
                pg8::Gemm gm; EpiAll E; pg8::StaticOrder S;
                E.lbp = p.hgrn_lb; E.rope = (const float2*)(p.ws + WS_ROPE); E.proj = proj; E.xp = p.x_prompt; E.xs = p.x_sample; E.out = p.out; E.g = g; E.layer = l;
                if (sub == 0)      { gm = pg8::Gemm{ubuf, (const bf16_t*)(p.ws + WS_WT1) + (size_t)l * 10240 * 1024, MG, NC1, 1024, 1024, 1024, nullptr, nullptr}; E.mode = 0; E.O = proj; E.bias = p.b_mg + l * 2048; S.init(MG, NC1, G, bid); }
                else if (sub == 4) { gm = pg8::Gemm{ubuf, (const bf16_t*)(p.ws + WS_WOUT) + (size_t)l * 1024 * 1024, MG, 1024, 1024, 1024, 1024, nullptr, nullptr}; E.mode = 3; E.O = ubuf; E.bias = (const float*)(p.ws + WS_ADA) + l * 18 * 3072; S.init(MG, 1024, G, bid); }
                else { gm = pg8::Gemm{proj + C_AG, (const bf16_t*)(p.ws + WS_WPA) + (size_t)l * 1024 * 1024, MG, 1024, 1024, NC1, 1024, proj + C_RG, (const bf16_t*)(p.ws + WS_WPB) + (size_t)l * 1024 * 1024}; E.mode = 1; E.O = ubuf; E.bias = nullptr;
                    if (extra) S.init(MG - 16384, 1024, 192, bid - 64, 64); else if (ovl) S.init(16384, 1024, G, bid); else S.init(MG, 1024, G, bid); }
                pg8::gemm_phase<EpiAll>(lds, gm, S, E);
            }
            if (sub == 5) {
                phase_ln(p, l, g, l == 0);
                if (l == 1 && g == 0) phase_prep(p, 0, 1);
            }
        }
        if (ph + 1 < p.ph_hi) { if (ph == 0) grid.sync(); else xcd_barrier(xbar); }
    }
}

#ifndef ONE_LAUNCH
#define ONE_LAUNCH 1
#endif
extern "C" void kernel_launch(void* const* d_in, const int* in_sizes, int n_in, void* d_out, int out_size, void* d_ws, size_t ws_size, hipStream_t stream) {
    static int grid = 0;
    if (grid == 0) {
        if (n_in != 17 || out_size != NTOK * D || ws_size < WS_END) { fprintf(stderr, "kernel_launch: unexpected shapes / workspace (n_in %d out %d ws %zu need %zu)\n", n_in, out_size, ws_size, (size_t)WS_END); grid = -1; return; }
        int dev = 0, cus = 0, per_cu = 0;
        hipGetDevice(&dev); hipDeviceGetAttribute(&cus, hipDeviceAttributeMultiprocessorCount, dev);
        if (hipFuncSetAttribute((const void*)fwd_megakernel, hipFuncAttributeMaxDynamicSharedMemorySize, LDS_BYTES) != hipSuccess) { fprintf(stderr, "kernel_launch: hipFuncSetAttribute failed\n"); grid = -1; return; }
        if (hipOccupancyMaxActiveBlocksPerMultiprocessor(&per_cu, (const void*)fwd_megakernel, 512, LDS_BYTES) != hipSuccess || per_cu < 1) { fprintf(stderr, "kernel_launch: occupancy query says %d\n", per_cu); per_cu = 1; }
        (void)hipGetLastError();
        grid = cus;
    }
    if (grid < 0) return;
    if (hipMemsetAsync((char*)d_ws + WS_BAR, 0, 16384, stream) != hipSuccess) { fprintf(stderr, "kernel_launch: memset of the barrier words failed\n"); return; }
    Params p{};
    p.x_prompt = (const float*)d_in[0]; p.x_sample = (const float*)d_in[1]; p.c_prompt = (const float*)d_in[2]; p.c_sample = (const float*)d_in[3];
    p.w_ada = (const float*)d_in[4]; p.b_ada = (const float*)d_in[5]; p.w_in = (const float*)d_in[6]; p.hgrn_lb = (const float*)d_in[7]; p.a_norm_w = (const float*)d_in[8];
    p.ret_decay = (const float*)d_in[9]; p.w_pa = (const float*)d_in[10]; p.w_pb = (const float*)d_in[11]; p.w_mg = (const float*)d_in[12]; p.b_mg = (const float*)d_in[13];
    p.w_out = (const float*)d_in[14]; p.ln_g = (const float*)d_in[15]; p.ln_b = (const float*)d_in[16];
    p.out = (float*)d_out; p.ws = (unsigned char*)d_ws;
#if ONE_LAUNCH
    p.ph_lo = 0; p.ph_hi = N_PHASES;
    void* args[] = {&p};
    hipError_t e = hipLaunchCooperativeKernel((const void*)fwd_megakernel, dim3(grid), dim3(512), args, LDS_BYTES, stream);
    if (e != hipSuccess) fprintf(stderr, "cooperative launch failed: %s (grid %d)\n", hipGetErrorString(e), grid);
#else
    for (int ph = 0; ph < N_PHASES; ++ph) { p.ph_lo = ph; p.ph_hi = ph + 1; hipLaunchKernelGGL(fwd_megakernel, dim3(grid), dim3(512), LDS_BYTES, stream, p); }
#endif
}
```

```cpp
#include <hip/hip_runtime.h>
#include <hip/hip_cooperative_groups.h>
#include <cstdio>
#include <cmath>
namespace cg = cooperative_groups;

#define LAS __attribute__((address_space(3)))
typedef unsigned short bf16_t;
typedef short bf16x8 __attribute__((ext_vector_type(8)));
typedef float f32x4 __attribute__((ext_vector_type(4)));
typedef unsigned u32x4 __attribute__((ext_vector_type(4)));
typedef unsigned u32x2 __attribute__((ext_vector_type(2)));
typedef float f32x2 __attribute__((ext_vector_type(2)));

constexpr int D = 1024, NTOK = 81920, NPTOK = 65536, NSEQ = 18, MG = 40960, NC1 = 10240;
constexpr int C_AQ = 0, C_AFF = 1024, C_AFB = 2048, C_AI = 3072, C_AG = 4096, C_RQ = 5120, C_RK = 5632, C_RV = 6144, C_RG = 7168, C_MG = 8192;
constexpr float LN_EPS = 1e-5f;
constexpr float DN_ALPHA = 1.41421356237309515f;

constexpr size_t WS_BAR = 0;
constexpr size_t WS_WT1 = 16384;
constexpr size_t WS_WPA = WS_WT1 + (size_t)2 * 10240 * 1024 * 2;
constexpr size_t WS_WPB = WS_WPA + (size_t)2 * 1024 * 1024 * 2;
constexpr size_t WS_WOUT = WS_WPB + (size_t)2 * 1024 * 1024 * 2;
constexpr size_t WS_ADA = WS_WOUT + (size_t)2 * 1024 * 1024 * 2;
constexpr size_t WS_ROPE = WS_ADA + (size_t)2 * 18 * 3072 * 4;
constexpr size_t WS_U = WS_ROPE + (size_t)8192 * 32 * 8;
constexpr size_t WS_OB = WS_U + (size_t)MG * 1024 * 2;
constexpr size_t WS_PROJ = WS_OB + (size_t)MG * 1024 * 2;
constexpr size_t WS_END = WS_PROJ + (size_t)MG * NC1 * 2;

struct Params {
    const float* x_prompt; const float* x_sample; const float* c_prompt; const float* c_sample;
    const float* w_ada; const float* b_ada; const float* w_in; const float* hgrn_lb; const float* a_norm_w; const float* ret_decay;
    const float* w_pa; const float* w_pb; const float* w_mg; const float* b_mg; const float* w_out; const float* ln_g; const float* ln_b;
    float* out; unsigned char* ws;
    int ph_lo, ph_hi;
};

__device__ __forceinline__ int grow(int g, int r) { return g == 0 ? (r < 16384 ? 65536 + r : r - 16384) : 24576 + r; }
__device__ __forceinline__ int seq_of(int gr) { return gr < 65536 ? (gr >> 12) : 16 + ((gr - 65536) >> 13); }
__device__ __forceinline__ unsigned cvt_pk_bf16(float lo, float hi) { unsigned r; asm("v_cvt_pk_bf16_f32 %0, %1, %2" : "=v"(r) : "v"(lo), "v"(hi)); return r; }
__device__ __forceinline__ bf16_t f2bf(float f) { return (bf16_t)(cvt_pk_bf16(f, 0.f) & 0xffffu); }
__device__ __forceinline__ float bf_lo(unsigned u) { return __uint_as_float(u << 16); }
__device__ __forceinline__ float bf_hi(unsigned u) { return __uint_as_float(u & 0xffff0000u); }
__device__ __forceinline__ float bf2f(bf16_t b) { return __uint_as_float(((unsigned)b) << 16); }
__device__ __forceinline__ float rcp_(float x) { return __builtin_amdgcn_rcpf(x); }
__device__ __forceinline__ float exp2_(float x) { return __builtin_amdgcn_exp2f(x); }
__device__ __forceinline__ float sigmoidf_(float x) { return rcp_(1.0f + exp2_(-1.4426950408889634f * x)); }

namespace pg8 {
constexpr int BM = 256, BK = 64, HALF = 128, HTB = HALF * BK * 2  , STAGE_BYTES = 8 * HTB, NXCD = 8, WGM = 8;
__host__ __device__ __forceinline__ int lds_byte(int r, int c) { const int st = (r >> 4) * 2 + (c >> 5), rr = r & 15, cc = c & 31, ob = rr * 64 + cc * 2; return st * 1024 + (ob ^ (((ob >> 9) & 1) << 5)); }
__host__ __device__ __forceinline__ void stage_rc(int b, int& R, int& C) { const int st = b / 1024, sb = b % 1024, swz = sb ^ (((sb >> 9) & 1) << 5); R = (st >> 1) * 16 + swz / 64; C = (st & 1) * 32 + (swz % 64) / 2; }
__host__ __device__ __forceinline__ int perm32(int rho) { const int n = rho >> 4, i = rho & 15; return 8 * (i >> 2) + 4 * n + (i & 3); }

struct Unit { int pm, pn; };
struct Gemm { const bf16_t* A; const bf16_t* Bt; int M, N, K, lda, ldb; const bf16_t* A2; const bf16_t* Bt2; };

struct StaticOrder {
    int nM, nN, nwg, G, c, pm0;
    __host__ __device__ void init(int M, int N, int G_, int c_, int pm0_ = 0) { nM = M / BM; nN = N / BM; nwg = nM * nN; G = G_; c = c_; pm0 = pm0_; }
    __host__ __device__ bool next(int i, Unit& u) const {
        const long L = (long)i * G + c; if (L >= nwg) return false;
        int wgid = (int)L; { const int q = nwg / NXCD, r = nwg % NXCD, xcd = wgid % NXCD, off = wgid / NXCD; wgid = (xcd < r ? xcd * (q + 1) : r * (q + 1) + (xcd - r) * q) + off; }
        const int nig = WGM * nN, gid = wgid / nig, fm = gid * WGM, gsz = (nM - fm) < WGM ? (nM - fm) : WGM;
        u.pm = pm0 + fm + ((wgid % nig) % gsz); u.pn = (wgid % nig) / gsz; return true;
    }
};

template <class Epi>
__device__ __forceinline__ void gemm_phase(LAS unsigned char* lds, const Gemm g, const StaticOrder& S, const Epi& E) {
    int tid_ = threadIdx.x; asm volatile("" : "+v"(tid_));
    const int tid = tid_, wid = __builtin_amdgcn_readfirstlane(tid >> 6), lane = tid & 63, wr = wid >> 2, wc = wid & 3, fr = lane & 15, fq = lane >> 4;
    const int K = g.K, nt = K / BK, npass = g.A2 ? 2 : 1;
    unsigned voffA[2], voffB[2];
#pragma unroll
    for (int i = 0; i < 2; ++i) { int R, C; stage_rc(tid * 16 + i * 8192, R, C); const int Rb = Epi::PERM ? ((R & ~31) + perm32(R & 31)) : R;
        voffA[i] = (unsigned)(R * g.lda + C) * 2u; voffB[i] = (unsigned)(Rb * g.ldb + C) * 2u; }
    const size_t kstep = (size_t)(BK * 2);
    const size_t hstepA = (size_t)HALF * g.lda * 2, hstepB = (size_t)HALF * g.ldb * 2;
    const size_t tstepA = 2 * hstepA, tstepB = 2 * hstepB;
    const unsigned ldsw = (unsigned)wid * 1024u;
    const int aoff = lds_byte(wr * 64 + fr, fq * 8), boff = lds_byte(wc * 32 + fr, fq * 8);
#define PG8_SA(b, h) (((b) * 2 + (h)) * HTB)
#define PG8_SB(b, h) ((4 + (b) * 2 + (h)) * HTB)
#define PG8_STAGE(bufoff, gbase, voff) do { _Pragma("unroll") for (int _i = 0; _i < 2; ++_i) \
        __builtin_amdgcn_global_load_lds((const unsigned*)((const char*)(gbase) + (voff)[_i]), (LAS unsigned*)(lds + (bufoff) + ldsw + _i * 8192), 16, 0, 0); } while (0)
#define PG8_LDA(dst, b, h) do { _Pragma("unroll") for (int m = 0; m < 4; ++m) _Pragma("unroll") for (int k = 0; k < 2; ++k) dst[m][k] = *(const LAS bf16x8*)(lds + PG8_SA(b, h) + aoff + m * 2048 + k * 1024); } while (0)
#define PG8_LDB(dst, b, h) do { _Pragma("unroll") for (int n = 0; n < 2; ++n) _Pragma("unroll") for (int k = 0; k < 2; ++k) dst[n][k] = *(const LAS bf16x8*)(lds + PG8_SB(b, h) + boff + n * 2048 + k * 1024); } while (0)
#define PG8_MMA(ai, bj, At, Bt) do { __builtin_amdgcn_s_setprio(1); _Pragma("unroll") for (int m = 0; m < 4; ++m) _Pragma("unroll") for (int n = 0; n < 2; ++n) _Pragma("unroll") for (int k = 0; k < 2; ++k) \
        acc[ai][bj][m][n] = __builtin_amdgcn_mfma_f32_16x16x32_bf16(Bt[n][k], At[m][k], acc[ai][bj][m][n], 0, 0, 0); __builtin_amdgcn_s_setprio(0); } while (0)
#define PG8_WAIT_V(n) asm volatile("s_waitcnt vmcnt(" #n ")" ::: "memory")
#define PG8_WAIT_L(n) asm volatile("s_waitcnt lgkmcnt(" #n ")" ::: "memory")
#define PG8_BAR __builtin_amdgcn_s_barrier()
#define PG8_SCHED __builtin_amdgcn_sched_barrier(0)
    Unit cur, nxt; int ui = 0;
    if (!S.next(0, cur)) return;
    f32x4 acc[2][2][4][2];
#pragma unroll
    for (int a = 0; a < 2; ++a)
#pragma unroll
        for (int b = 0; b < 2; ++b)
#pragma unroll
            for (int m = 0; m < 4; ++m)
#pragma unroll
                for (int n = 0; n < 2; ++n) acc[a][b][m][n] = (f32x4){0.f, 0.f, 0.f, 0.f};
    bf16x8 At[4][2], B0[2][2], B1[2][2];
    const char* cA = (const char*)g.A + (size_t)cur.pm * tstepA; const char* cB = (const char*)g.Bt + (size_t)cur.pn * tstepB;
    PG8_STAGE(PG8_SB(0, 0), cB, voffB); PG8_STAGE(PG8_SA(0, 0), cA, voffA); PG8_STAGE(PG8_SB(0, 1), cB + hstepB, voffB); PG8_STAGE(PG8_SA(0, 1), cA + hstepA, voffA);
    if (wr == 1) PG8_BAR;
    PG8_WAIT_V(4); PG8_BAR;
    PG8_STAGE(PG8_SB(1, 0), cB + kstep, voffB); PG8_STAGE(PG8_SA(1, 0), cA + kstep, voffA); PG8_STAGE(PG8_SB(1, 1), cB + hstepB + kstep, voffB);
    PG8_WAIT_V(6); PG8_BAR;
    for (;;) {
        const bool has_next = S.next(ui + 1, nxt);
        const char* nA = cA; const char* nB = cB;
        for (int pass = 0; pass < npass; ++pass) {
        const bool lastpass = (pass == npass - 1);
        if (!lastpass) { nA = (const char*)g.A2 + (size_t)cur.pm * tstepA; nB = (const char*)g.Bt2 + (size_t)cur.pn * tstepB; }
        else if (has_next) { nA = (const char*)g.A + (size_t)nxt.pm * tstepA; nB = (const char*)g.Bt + (size_t)nxt.pn * tstepB; }
        else { nA = cA; nB = cB; }
        for (int t = 0; t < nt; t += 2) {
            const bool last = (t == nt - 2);
            const char* a1 = cA + (size_t)(t + 1) * kstep;
            const char* a2 = last ? nA : cA + (size_t)(t + 2) * kstep; const char* b2 = last ? nB : cB + (size_t)(t + 2) * kstep;
            const char* a3 = a2 + kstep; const char* b3 = b2 + kstep;
            PG8_LDB(B0, 0, 0); PG8_SCHED; PG8_LDA(At, 0, 0); PG8_STAGE(PG8_SA(1, 1), a1 + hstepA, voffA);
            PG8_WAIT_L(8); PG8_BAR; PG8_WAIT_L(0); PG8_MMA(0, 0, At, B0); PG8_BAR; PG8_SCHED;
            PG8_LDB(B1, 0, 1); PG8_STAGE(PG8_SB(0, 0), b2, voffB);
            PG8_BAR; PG8_WAIT_L(0); PG8_MMA(0, 1, At, B1); PG8_BAR;
            PG8_LDA(At, 0, 1); PG8_STAGE(PG8_SA(0, 0), a2, voffA);
            PG8_BAR; PG8_WAIT_L(0); PG8_MMA(1, 0, At, B0); PG8_BAR; PG8_SCHED;
            PG8_STAGE(PG8_SB(0, 1), b2 + hstepB, voffB);
            PG8_WAIT_V(6); PG8_BAR; PG8_MMA(1, 1, At, B1); PG8_BAR;
            PG8_LDB(B0, 1, 0); PG8_SCHED; PG8_LDA(At, 1, 0); PG8_STAGE(PG8_SA(0, 1), a2 + hstepA, voffA);
            PG8_WAIT_L(8); PG8_BAR; PG8_WAIT_L(0); PG8_MMA(0, 0, At, B0); PG8_BAR; PG8_SCHED;
            PG8_LDB(B1, 1, 1); PG8_STAGE(PG8_SB(1, 0), b3, voffB);
            PG8_BAR; PG8_WAIT_L(0); PG8_MMA(0, 1, At, B1); PG8_BAR;
            PG8_LDA(At, 1, 1); PG8_STAGE(PG8_SA(1, 0), a3, voffA);
            PG8_BAR; PG8_WAIT_L(0); PG8_MMA(1, 0, At, B0); PG8_BAR; PG8_SCHED;
            PG8_STAGE(PG8_SB(1, 1), b3 + hstepB, voffB);
            PG8_WAIT_V(6); PG8_BAR; PG8_MMA(1, 1, At, B1); PG8_BAR;
        }
        if (!lastpass) { E.mid(acc, cur, wr, wc, fr, fq); cA = nA; cB = nB; }
        }
        E(acc, cur, wr, wc, fr, fq);
        if (!has_next) break;
#pragma unroll
        for (int a = 0; a < 2; ++a)
#pragma unroll
            for (int b = 0; b < 2; ++b)
#pragma unroll
                for (int m = 0; m < 4; ++m)
#pragma unroll
                    for (int n = 0; n < 2; ++n) acc[a][b][m][n] = (f32x4){0.f, 0.f, 0.f, 0.f};
        cur = nxt; cA = nA; cB = nB; ++ui;
    }
    PG8_WAIT_V(0);
    if (wr == 0) PG8_BAR;
    PG8_BAR;
#undef PG8_SA
#undef PG8_SB
#undef PG8_STAGE
#undef PG8_LDA
#undef PG8_LDB
#undef PG8_MMA
#undef PG8_WAIT_V
#undef PG8_WAIT_L
#undef PG8_BAR
#undef PG8_SCHED
}
}

#define XB_TMO      128
#define XB_XCNT(j)  (256  + 64 * (j))
#define XB_XSUB(j)  (1280 + 64 * (j))
#define XB_XGEN(j)  (2304 + 64 * (j))
#define XB_TOP      3328
#define XB_TOPGEN   3392
#define XCD_BAR_WORDS 3456
#define XB_SPIN_CAP (1u << 18)

__device__ __forceinline__ unsigned xb_ld(unsigned* p)              { return __hip_atomic_load(p, __ATOMIC_RELAXED, __HIP_MEMORY_SCOPE_AGENT); }
__device__ __forceinline__ unsigned xb_add(unsigned* p, unsigned v) { return __hip_atomic_fetch_add(p, v, __ATOMIC_RELAXED, __HIP_MEMORY_SCOPE_AGENT); }
__device__ __forceinline__ unsigned xb_xcc_id() { return (unsigned)__builtin_amdgcn_s_getreg((3 << 11) | 20) & 0xFu; }
#define XB_SPIN(cond, bar) do { unsigned _sp = 0; while (cond) { __builtin_amdgcn_s_sleep(1); \
    if ((++_sp & 255u) == 0u) { if (xb_ld(&(bar)[XB_TMO])) break; if (_sp > XB_SPIN_CAP) { atomicAdd(&(bar)[XB_TMO], 1u); break; } } } } while (0)

struct XcdBarrier {
    unsigned* bar; unsigned x;
    volatile LAS unsigned* st;
};

__device__ __forceinline__ XcdBarrier xcd_barrier_post(unsigned* bar, volatile LAS unsigned* st) {
    XcdBarrier b; b.bar = bar; b.x = xb_xcc_id(); b.st = st;
    if (threadIdx.x == 0) (void)xb_add(&bar[XB_XCNT(b.x)], 1u);
    return b;
}
__device__ __forceinline__ void xcd_barrier_complete(unsigned* bar, unsigned x, unsigned& nloc, unsigned& nx) {
    const unsigned G = gridDim.x * gridDim.y * gridDim.z;
    unsigned sum, cnt, mine, sp = 0u;
    for (;;) {
        sum = 0u; cnt = 0u; mine = 0u;
#pragma unroll
        for (unsigned j = 0; j < 16; ++j) { const unsigned c = xb_ld(&bar[XB_XCNT(j)]); sum += c; cnt += (c > 0u) ? 1u : 0u; mine = (j == x) ? c : mine; }
        if (sum == G) break;
        __builtin_amdgcn_s_sleep(1);
        if ((++sp & 255u) == 0u) { if (xb_ld(&bar[XB_TMO])) break; if (sp > XB_SPIN_CAP) { atomicAdd(&bar[XB_TMO], 1u); break; } }
    }
    nloc = mine > 0u ? mine : 1u; nx = cnt > 0u ? cnt : 1u;
}

__device__ __forceinline__ void xcd_barrier(const XcdBarrier& b) {
    asm volatile("s_waitcnt vmcnt(0)" ::: "memory");
    __syncthreads();
    if (threadIdx.x == 0) {
        unsigned* bar = b.bar;
        __builtin_amdgcn_s_waitcnt(0);
        unsigned nloc = b.st[0], nx = b.st[1];
        if (nloc == 0u) { xcd_barrier_complete(bar, b.x, nloc, nx); b.st[0] = nloc; b.st[1] = nx; }
        const unsigned old = xb_add(&bar[XB_XSUB(b.x)], 1u);
        const unsigned gen = old / nloc;
        if (old + 1u == (gen + 1u) * nloc) {
            __builtin_amdgcn_fence(__ATOMIC_RELEASE, "agent");
            asm volatile("s_waitcnt vmcnt(0)" ::: "memory");
            const unsigned og = xb_add(&bar[XB_TOP], 1u);
            const unsigned tg = og / nx;
            if (og + 1u == (tg + 1u) * nx) xb_add(&bar[XB_TOPGEN], 1u);
            else XB_SPIN(xb_ld(&bar[XB_TOPGEN]) == tg, bar);
            __builtin_amdgcn_fence(__ATOMIC_ACQUIRE, "agent");
            xb_add(&bar[XB_XGEN(b.x)], 1u);
            asm volatile("s_waitcnt vmcnt(0)" ::: "memory");
        } else {
            XB_SPIN(xb_ld(&bar[XB_XGEN(b.x)]) == gen, bar);
            __builtin_amdgcn_fence(__ATOMIC_ACQUIRE, "agent");
            asm volatile("s_waitcnt vmcnt(0)" ::: "memory");
        }
    }
    __syncthreads();
}


__device__ __forceinline__ void subset_barrier(unsigned* ctr, unsigned target) {
    asm volatile("s_waitcnt vmcnt(0)" ::: "memory");
    __syncthreads();
    if (threadIdx.x == 0) {
        __builtin_amdgcn_fence(__ATOMIC_RELEASE, "agent");
        asm volatile("s_waitcnt vmcnt(0)" ::: "memory");
        (void)xb_add(ctr, 1u);
        unsigned sp = 0u;
        while (xb_ld(ctr) < target) { __builtin_amdgcn_s_sleep(2); if (++sp > (1u << 22)) break; }
        __builtin_amdgcn_fence(__ATOMIC_ACQUIRE, "agent");
        asm volatile("s_waitcnt vmcnt(0)" ::: "memory");
    }
    __syncthreads();
}

__device__ __forceinline__ int rope_pos(int g, int row) { const int gr = grow(g, row); return gr < NPTOK ? (gr & 4095) : ((gr - NPTOK) & 8191); }
struct EpiAll {
    static constexpr bool PERM = true;
    int mode;
    bf16_t* O; const bf16_t* proj; const float* bias;
    const float* xp; const float* xs; float* out; int g, layer;
    const float* lbp; const float2* rope;
    __device__ __forceinline__ void mid(f32x4 (&acc)[2][2][4][2], const pg8::Unit& u, int wr, int wc, int fr_in, int fq_in) const {
        int fr = fr_in, fq = fq_in; asm volatile("" : "+v"(fr), "+v"(fq));
        const int row0 = u.pm * 256 + wr * 64 + fr, col0 = u.pn * 256 + wc * 32 + 8 * fq;
#pragma unroll
        for (int i = 0; i < 16; ++i) { const int ai = i >> 3, m = (i >> 1) & 3, bj = i & 1; const int n = col0 + bj * 128;
            const u32x4 gq = *(const u32x4*)(proj + (size_t)(row0 + ai * 128 + m * 16) * NC1 + C_MG + (n >> 7) * 256 + (n & 127));
            acc[ai][bj][m][0][0] *= bf_lo(gq.x); acc[ai][bj][m][0][1] *= bf_hi(gq.x); acc[ai][bj][m][0][2] *= bf_lo(gq.y); acc[ai][bj][m][0][3] *= bf_hi(gq.y);
            acc[ai][bj][m][1][0] *= bf_lo(gq.z); acc[ai][bj][m][1][1] *= bf_hi(gq.z); acc[ai][bj][m][1][2] *= bf_lo(gq.w); acc[ai][bj][m][1][3] *= bf_hi(gq.w); }
    }
    __device__ __forceinline__ void operator()(const f32x4 (&acc)[2][2][4][2], const pg8::Unit& u, int wr, int wc, int fr_in, int fq_in) const {
        int fr = fr_in, fq = fq_in; asm volatile("" : "+v"(fr), "+v"(fq));
        const int row0 = u.pm * 256 + wr * 64 + fr, col0 = u.pn * 256 + wc * 32 + 8 * fq;
        if (mode == 0) {
            const int pn = u.pn;
            const int kind = (pn < 4) ? 1 : (pn < 12) ? 2 : (pn < 20) ? 0 : (pn < 24) ? 4 : (pn < 32) ? 0 : 5;
            f32x4 den[2][4][2];
#pragma unroll
            for (int bj = 0; bj < 2; ++bj) {
                const int col = col0 + bj * 128;
                f32x4 b0 = (f32x4){0.f, 0.f, 0.f, 0.f}, b1 = b0, c0 = (f32x4){1.f, 1.f, 1.f, 1.f}, c1 = c0;
                if (kind == 5) { const int nb = (pn - 32) * 128 + wc * 32 + 8 * fq + bj * 1024; b0 = *(const f32x4*)(bias + nb); b1 = *(const f32x4*)(bias + nb + 4); }
                if (kind == 2) {
                    if (layer == 1) { const int ch = col & 1023;
                        const f32x4 a0 = *(const f32x4*)(lbp + ch), a1 = *(const f32x4*)(lbp + ch + 4), d0 = *(const f32x4*)(lbp + 1024 + ch), d1 = *(const f32x4*)(lbp + 1024 + ch + 4);
#pragma unroll
                        for (int j = 0; j < 4; ++j) { const float l0 = sigmoidf_(d0[j] - a0[j]), l1 = sigmoidf_(d1[j] - a1[j]);
                            b0[j] = fmaxf(l0, 1e-30f); b1[j] = fmaxf(l1, 1e-30f); c0[j] = 1.0f - l0; c1[j] = 1.0f - l1; } }
                    else { b0 = (f32x4){1e-30f, 1e-30f, 1e-30f, 1e-30f}; b1 = b0; } }
                f32x4 rr0[4], rr1[4];
#define ROPE_PTR(idx) ((const f32x4*)(rope + (size_t)rope_pos(g, row0 + (((idx) >> 2) & 1) * 128 + ((idx) & 3) * 16) * 32 + ((col & 63) >> 1)))
                if (kind == 4) {
#pragma unroll
                    for (int k = 0; k < 4; ++k) { const f32x4* rp = ROPE_PTR(k); rr0[k] = rp[0]; rr1[k] = rp[1]; } }
#pragma unroll
                for (int ai = 0; ai < 2; ++ai)
#pragma unroll
                    for (int m = 0; m < 4; ++m) { f32x4 v0 = acc[ai][bj][m][0], v1 = acc[ai][bj][m][1];
                        const int row = row0 + ai * 128 + m * 16;
                        if (kind == 1) {
#pragma unroll
                            for (int j = 0; j < 4; ++j) { v0[j] = v0[j] * sigmoidf_(v0[j]) * 0.08838834764831845f; v1[j] = v1[j] * sigmoidf_(v1[j]) * 0.08838834764831845f; }
                        } else if (kind == 2) {
#pragma unroll
                            for (int j = 0; j < 4; ++j) { const float x0 = fminf(fmaxf(v0[j], -30.f), 30.f), x1 = fminf(fmaxf(v1[j], -30.f), 30.f);
                                v0[j] = __builtin_amdgcn_logf(b0[j] + c0[j] * sigmoidf_(x0)); v1[j] = __builtin_amdgcn_logf(b1[j] + c1[j] * sigmoidf_(x1)); }
                        } else if (kind == 3) {
#pragma unroll
                            for (int j = 0; j < 4; ++j) { v0[j] = v0[j] * sigmoidf_(v0[j]); v1[j] = v1[j] * sigmoidf_(v1[j]); }
                        } else if (kind == 4) {
                            const int idx = ai * 4 + m;
                            const f32x4 r0 = rr0[idx & 3], r1 = rr1[idx & 3]; const float qs = (pn < 22) ? 0.125f : 1.0f;
                            if (idx + 4 < 8) { const f32x4* rp = ROPE_PTR(idx + 4); rr0[idx & 3] = rp[0]; rr1[idx & 3] = rp[1]; }
                            f32x4 w0, w1;
                            w0[0] = (v0[0] * r0[0] - v0[1] * r0[1]) * qs; w0[1] = (v0[0] * r0[1] + v0[1] * r0[0]) * qs; w0[2] = (v0[2] * r0[2] - v0[3] * r0[3]) * qs; w0[3] = (v0[2] * r0[3] + v0[3] * r0[2]) * qs;
                            w1[0] = (v1[0] * r1[0] - v1[1] * r1[1]) * qs; w1[1] = (v1[0] * r1[1] + v1[1] * r1[0]) * qs; w1[2] = (v1[2] * r1[2] - v1[3] * r1[3]) * qs; w1[3] = (v1[2] * r1[3] + v1[3] * r1[2]) * qs;
                            v0 = w0; v1 = w1;
                        } else if (kind == 5) {
                            v0 += b0; v1 += b1;
#pragma unroll
                            for (int j = 0; j < 4; ++j) { v0[j] = 1.0f + exp2_(-1.4426950408889634f * v0[j]); v1[j] = 1.0f + exp2_(-1.4426950408889634f * v1[j]); }
                            if (bj == 0) { den[ai][m][0] = v0; den[ai][m][1] = v1; continue; }
                            f32x4 s0, s1, q0, q1;
#pragma unroll
                            for (int j = 0; j < 4; ++j) { s0[j] = rcp_(v0[j]); s1[j] = rcp_(v1[j]); q0[j] = v0[j] * rcp_(den[ai][m][0][j]); q1[j] = v1[j] * rcp_(den[ai][m][1][j]); }
                            u32x4 wq; wq.x = cvt_pk_bf16(q0[0], q0[1]); wq.y = cvt_pk_bf16(q0[2], q0[3]); wq.z = cvt_pk_bf16(q1[0], q1[1]); wq.w = cvt_pk_bf16(q1[2], q1[3]);
                            *(u32x4*)(O + (size_t)row * NC1 + col - 128) = wq;
                            v0 = s0; v1 = s1; }
                        u32x4 w; w.x = cvt_pk_bf16(v0[0], v0[1]); w.y = cvt_pk_bf16(v0[2], v0[3]); w.z = cvt_pk_bf16(v1[0], v1[1]); w.w = cvt_pk_bf16(v1[2], v1[3]);
                        *(u32x4*)(O + (size_t)row * NC1 + col) = w;
                        } }
        } else if (mode == 3) {
            const int gr0 = grow(g, u.pm * 256), s = seq_of(gr0);
            const float* xb = layer ? (const float*)out + (size_t)gr0 * 1024 : (gr0 < NPTOK ? xp + (size_t)gr0 * 1024 : xs + (size_t)(gr0 - NPTOK) * 1024);
            float* ob = out + (size_t)gr0 * 1024;
            const int rl0 = wr * 64 + fr;
            f32x4 gv[2][2];
#pragma unroll
            for (int bj = 0; bj < 2; ++bj) { gv[bj][0] = *(const f32x4*)(bias + s * 3072 + 2048 + col0 + bj * 128) + 1.0f; gv[bj][1] = *(const f32x4*)(bias + s * 3072 + 2048 + col0 + bj * 128 + 4) + 1.0f; }
            f32x4 xr[4][2];
#define E3_OFF(i) ((size_t)(rl0 + ((i) >> 3) * 128 + (((i) >> 1) & 3) * 16) * 1024 + col0 + ((i) & 1) * 128)
#pragma unroll
            for (int k = 0; k < 4; ++k) { xr[k][0] = *(const f32x4*)(xb + E3_OFF(k)); xr[k][1] = *(const f32x4*)(xb + E3_OFF(k) + 4); }
#pragma unroll
            for (int i = 0; i < 16; ++i) {
                const f32x4 x0 = xr[i & 3][0], x1 = xr[i & 3][1];
                if (i + 4 < 16) { xr[i & 3][0] = *(const f32x4*)(xb + E3_OFF(i + 4)); xr[i & 3][1] = *(const f32x4*)(xb + E3_OFF(i + 4) + 4); }
                const int ai = i >> 3, m = (i >> 1) & 3, bj = i & 1;
                *(f32x4*)(ob + E3_OFF(i)) = x0 * DN_ALPHA + gv[bj][0] * acc[ai][bj][m][0]; *(f32x4*)(ob + E3_OFF(i) + 4) = x1 * DN_ALPHA + gv[bj][1] * acc[ai][bj][m][1];
            }
#undef E3_OFF
        } else {
            u32x4 gr[4];
#define E2_ROW(i) ((size_t)(row0 + ((i) >> 3) * 128 + (((i) >> 1) & 3) * 16))
#define E2_COL(i) (col0 + ((i) & 1) * 128)
#define E2_G(i) (C_MG + (E2_COL(i) >> 7) * 256 + 128 + (E2_COL(i) & 127))
#pragma unroll
            for (int k = 0; k < 4; ++k) gr[k] = *(const u32x4*)(proj + E2_ROW(k) * NC1 + E2_G(k));
#pragma unroll
            for (int i = 0; i < 16; ++i) {
                const u32x4 ga = gr[i & 3];
                if (i + 4 < 16) gr[i & 3] = *(const u32x4*)(proj + E2_ROW(i + 4) * NC1 + E2_G(i + 4));
                const int ai = i >> 3, m = (i >> 1) & 3, bj = i & 1;
                f32x4 v0 = acc[ai][bj][m][0], v1 = acc[ai][bj][m][1];
                v0[0] *= bf_lo(ga.x); v0[1] *= bf_hi(ga.x); v0[2] *= bf_lo(ga.y); v0[3] *= bf_hi(ga.y);
                v1[0] *= bf_lo(ga.z); v1[1] *= bf_hi(ga.z); v1[2] *= bf_lo(ga.w); v1[3] *= bf_hi(ga.w);
                u32x4 w; w.x = cvt_pk_bf16(v0[0], v0[1]); w.y = cvt_pk_bf16(v0[2], v0[3]); w.z = cvt_pk_bf16(v1[0], v1[1]); w.w = cvt_pk_bf16(v1[2], v1[3]);
                *(u32x4*)(O + E2_ROW(i) * 1024 + E2_COL(i)) = w;
            }
#undef E2_ROW
#undef E2_COL
#undef E2_G
        }
    }
};

__device__ __forceinline__ void phase_init(const Params& p, LAS unsigned char* lds) {
    int tid_ = threadIdx.x; asm volatile("" : "+v"(tid_));
    const int tid = tid_, nb = gridDim.x, b = blockIdx.x;
    LAS float* tile = (LAS float*)lds;
    for (int u = b; u < 2 * 208 * 16; u += nb) {
        const int l = u / (208 * 16), rem = u % (208 * 16), ntile = rem >> 4, kt = rem & 15;
        const float* src; int ldsrc, ncol0; bf16_t* dst;
        if (ntile < 128)      { src = p.w_in + (size_t)l * 1024 * 8192; ldsrc = 8192; ncol0 = ntile * 64;         dst = (bf16_t*)(p.ws + WS_WT1) + ((size_t)l * 10240 + ncol0) * 1024; }
        else if (ntile < 160) { src = p.w_mg + (size_t)l * 1024 * 2048; ldsrc = 2048; ncol0 = (ntile - 128) * 64; dst = (bf16_t*)(p.ws + WS_WT1) + ((size_t)l * 10240 + 8192 + ncol0) * 1024; }
        else if (ntile < 176) { src = p.w_pa + (size_t)l * 1024 * 1024; ldsrc = 1024; ncol0 = (ntile - 160) * 64; dst = (bf16_t*)(p.ws + WS_WPA) + ((size_t)l * 1024 + ncol0) * 1024; }
        else if (ntile < 192) { src = p.w_pb + (size_t)l * 1024 * 1024; ldsrc = 1024; ncol0 = (ntile - 176) * 64; dst = (bf16_t*)(p.ws + WS_WPB) + ((size_t)l * 1024 + ncol0) * 1024; }
        else                  { src = p.w_out + (size_t)l * 1024 * 1024; ldsrc = 1024; ncol0 = (ntile - 192) * 64; dst = (bf16_t*)(p.ws + WS_WOUT) + ((size_t)l * 1024 + ncol0) * 1024; }
        const int k0 = kt * 64;
        { const int kr = tid >> 3, c8 = (tid & 7) * 8; const float* s = src + (size_t)(k0 + kr) * ldsrc + ncol0 + c8;
          const f32x4 a = *(const f32x4*)s, c = *(const f32x4*)(s + 4);
#pragma unroll
          for (int j = 0; j < 4; ++j) { tile[kr * 65 + c8 + j] = a[j]; tile[kr * 65 + c8 + 4 + j] = c[j]; } }
        __syncthreads();
        { const int n = tid >> 3, kg = (tid & 7) * 8; float v[8];
#pragma unroll
          for (int j = 0; j < 8; ++j) v[j] = tile[(kg + j) * 65 + n];
          u32x4 w; w.x = cvt_pk_bf16(v[0], v[1]); w.y = cvt_pk_bf16(v[2], v[3]); w.z = cvt_pk_bf16(v[4], v[5]); w.w = cvt_pk_bf16(v[6], v[7]);
          int np = n;
          if (ntile >= 80 && ntile < 96) np = ((n & 31) << 1) | (n >> 5);
          if (ntile >= 128 && ntile < 160) { const int L = (ntile - 128) * 64 + n, which = L >> 10, nn = L & 1023; np = (nn >> 7) * 256 + which * 128 + (nn & 127) - (ntile - 128) * 64; }
          *(u32x4*)(dst + (ptrdiff_t)np * 1024 + k0 + kg) = w; }
        __syncthreads();
    }
    float* adap = (float*)(p.ws + WS_PROJ);
    for (int u = b; u < 96; u += nb) {
        const int cb = u % 6, ks = (u / 6) % 8, l = u / 48;
        __syncthreads();
        for (int e = tid; e < 18 * 128; e += 512) { const int s = e >> 7, k = e & 127;
            const float c = (s < 16) ? p.c_prompt[s * 1024 + ks * 128 + k] : p.c_sample[(s - 16) * 1024 + ks * 128 + k];
            tile[e] = c / (1.0f + __expf(-c)); }
        __syncthreads();
        const int n = cb * 512 + tid; float acc[18];
#pragma unroll
        for (int s = 0; s < 18; ++s) acc[s] = 0.f;
        const float* w = p.w_ada + (size_t)l * 1024 * 3072 + (size_t)(ks * 128) * 3072 + n;
#pragma unroll 4
        for (int k = 0; k < 128; ++k) { const float wv = w[(size_t)k * 3072];
#pragma unroll
            for (int s = 0; s < 18; ++s) acc[s] += tile[s * 128 + k] * wv; }
#pragma unroll
        for (int s = 0; s < 18; ++s) adap[(size_t)((ks * 2 + l) * 18 + s) * 3072 + n] = acc[s];
    }
    float2* rope = (float2*)(p.ws + WS_ROPE);
    for (int e = b * 512 + tid; e < 8192 * 32; e += nb * 512) {
        const int pos = e >> 5, i = e & 31;
        double inv = 1.0; for (int k = 0; k < i; ++k) inv *= 0.7498942093324559;
        const double rev = (double)pos * inv * 0.15915494309189533577;
        double fr = rev - floor(rev); if (fr > 0.5) fr -= 1.0;
        const double r = fr * 6.28318530717958647692, r2 = r * r;
        double s = 1.0, c = 1.0;
#pragma unroll
        for (int n = 13; n >= 1; --n) { s = 1.0 - s * r2 * (1.0 / (double)((2 * n) * (2 * n + 1))); c = 1.0 - c * r2 * (1.0 / (double)((2 * n - 1) * (2 * n))); }
        rope[e] = make_float2((float)c, (float)(s * r));
    }
}

__device__ __forceinline__ void phase_ada_fin(const Params& p) {
    const float* adap = (const float*)(p.ws + WS_PROJ); float* ada = (float*)(p.ws + WS_ADA);
    int tid_ = threadIdx.x; asm volatile("" : "+v"(tid_));
    for (int e = blockIdx.x * 512 + tid_; e < 2 * 18 * 3072; e += gridDim.x * 512) {
        const int l = e / (18 * 3072), n = e % 3072; float a = p.b_ada[l * 3072 + n];
#pragma unroll
        for (int ks = 0; ks < 8; ++ks) a += adap[(size_t)ks * 110592 + e];
        ada[e] = a;
    }
}

__device__ __forceinline__ void phase_prep(const Params& p, int l, int g) {
    int tid_ = threadIdx.x; asm volatile("" : "+v"(tid_));
    const int tid = tid_; const float* ada = (const float*)(p.ws + WS_ADA) + l * 18 * 3072;
    unsigned* U32 = (unsigned*)(p.ws + WS_U);
    for (int strip = blockIdx.x; strip < MG / 16; strip += gridDim.x) {
        const int r0 = strip * 16, gr0 = grow(g, r0), s = seq_of(gr0);
        const float* src = l ? (const float*)p.out + (size_t)gr0 * 1024 : (gr0 < NPTOK ? p.x_prompt + (size_t)gr0 * 1024 : p.x_sample + (size_t)(gr0 - NPTOK) * 1024);
        const float2 sh = *(const float2*)(ada + s * 3072 + 2 * tid), sc = *(const float2*)(ada + s * 3072 + 1024 + 2 * tid);
#pragma unroll 8
        for (int i = 0; i < 16; ++i) { const f32x2 xv = l ? *(const f32x2*)(src + (size_t)i * 1024 + 2 * tid) : __builtin_nontemporal_load((const f32x2*)(src + (size_t)i * 1024 + 2 * tid)); const float2 x = make_float2(xv.x, xv.y);
            U32[(size_t)(r0 + i) * 512 + tid] = cvt_pk_bf16(x.x * (1.0f + sc.x) + sh.x, x.y * (1.0f + sc.y) + sh.y); }
    }
}

__device__ __forceinline__ void ln_row(float* row, const f32x4 (&vin)[4], const float* gam, const float* bet, int lane, const float* ada_next, unsigned* urow) {
    f32x4 v[4]; float s = 0.f;
#pragma unroll
    for (int i = 0; i < 4; ++i) { v[i] = vin[i]; s += (v[i][0] + v[i][1]) + (v[i][2] + v[i][3]); }
#pragma unroll
    for (int o = 32; o >= 1; o >>= 1) s += __shfl_xor(s, o);
    const float mu = s * (1.0f / 1024.0f); float q = 0.f;
#pragma unroll
    for (int i = 0; i < 4; ++i) { v[i] -= mu; q += (v[i][0] * v[i][0] + v[i][1] * v[i][1]) + (v[i][2] * v[i][2] + v[i][3] * v[i][3]); }
#pragma unroll
    for (int o = 32; o >= 1; o >>= 1) q += __shfl_xor(q, o);
    const float rstd = 1.0f / sqrtf(q * (1.0f / 1024.0f) + LN_EPS);
#pragma unroll
    for (int i = 0; i < 4; ++i) { const f32x4 gm = *(const f32x4*)(gam + i * 256 + lane * 4), bt = *(const f32x4*)(bet + i * 256 + lane * 4);
        const f32x4 y = v[i] * rstd * gm + bt;
        if (ada_next) *(f32x4*)(row + i * 256 + lane * 4) = y; else __builtin_nontemporal_store(y, (f32x4*)(row + i * 256 + lane * 4));
        if (ada_next) { const f32x4 sh = *(const f32x4*)(ada_next + i * 256 + lane * 4), sc = *(const f32x4*)(ada_next + 1024 + i * 256 + lane * 4); const f32x4 uu = y * (sc + 1.0f) + sh;
            u32x2 pk; pk.x = cvt_pk_bf16(uu[0], uu[1]); pk.y = cvt_pk_bf16(uu[2], uu[3]); *(u32x2*)(urow + i * 128 + lane * 2) = pk; } }
}
__device__ __forceinline__ void phase_ln(const Params& p, int l, int g, bool emit_u) {
    int tid_ = threadIdx.x; asm volatile("" : "+v"(tid_));
    const int lane = tid_ & 63, wv = tid_ >> 6;
    const float* gam = p.ln_g + l * 1024; const float* bet = p.ln_b + l * 1024;
    const int stride = gridDim.x * 8;
    for (int r = blockIdx.x * 8 + wv; r < MG; r += 4 * stride) {
        float* rows[4]; f32x4 v[4][4];
#pragma unroll
        for (int k = 0; k < 4; ++k) { const int rr = r + k * stride; rows[k] = p.out + (size_t)grow(g, rr < MG ? rr : r) * 1024;
#pragma unroll
            for (int i = 0; i < 4; ++i) v[k][i] = __builtin_nontemporal_load((const f32x4*)(rows[k] + i * 256 + lane * 4)); }
#pragma unroll
        for (int k = 0; k < 4; ++k) if (r + k * stride < MG) { const int rr = r + k * stride; const int sq = seq_of(grow(g, rr));
            ln_row(rows[k], v[k], gam, bet, lane, emit_u ? (const float*)(p.ws + WS_ADA) + (l + 1) * 18 * 3072 + sq * 3072 : nullptr, (unsigned*)(p.ws + WS_U) + (size_t)rr * 512); }
    }
}

struct CombIn { u32x4 a, b, g; };
__device__ __forceinline__ void comb_ptrs(const Params& p, int u, int sub, const bf16_t*& pf, const bf16_t*& pb, bf16_t*& pg) {
    bf16_t* proj = (bf16_t*)(p.ws + WS_PROJ); const bf16_t* of_r = (const bf16_t*)(p.ws + WS_U); const bf16_t* ob_r = (const bf16_t*)(p.ws + WS_OB);
    const int r = u >> 4, mh = u & 15; const bool isA = mh < 8; const int h = mh & 7;
    pf = isA ? proj + (size_t)r * NC1 + C_AFF + h * 128 + sub * 8 : of_r + (size_t)r * 1024 + h * 128 + sub * 8;
    pb = isA ? proj + (size_t)r * NC1 + C_AFB + h * 128 + sub * 8 : ob_r + (size_t)r * 1024 + h * 128 + sub * 8;
    pg = proj + (size_t)r * NC1 + (isA ? C_AG : C_RG) + h * 128 + sub * 8;
}
__device__ __forceinline__ void comb_unit(const CombIn& in, bool isA, const f32x4& nw0, const f32x4& nw1, bf16_t* pg) {
    const u32x4 a = in.a, bq = in.b, gq = in.g;
    float o[8], gt[8];
    o[0] = bf_lo(a.x) + bf_lo(bq.x); o[1] = bf_hi(a.x) + bf_hi(bq.x); o[2] = bf_lo(a.y) + bf_lo(bq.y); o[3] = bf_hi(a.y) + bf_hi(bq.y);
    o[4] = bf_lo(a.z) + bf_lo(bq.z); o[5] = bf_hi(a.z) + bf_hi(bq.z); o[6] = bf_lo(a.w) + bf_lo(bq.w); o[7] = bf_hi(a.w) + bf_hi(bq.w);
    gt[0] = bf_lo(gq.x); gt[1] = bf_hi(gq.x); gt[2] = bf_lo(gq.y); gt[3] = bf_hi(gq.y); gt[4] = bf_lo(gq.z); gt[5] = bf_hi(gq.z); gt[6] = bf_lo(gq.w); gt[7] = bf_hi(gq.w);
    if (!isA) { float s = 0.f;
#pragma unroll
        for (int j = 0; j < 8; ++j) s += o[j];
        s += __shfl_xor(s, 1); s += __shfl_xor(s, 2); s += __shfl_xor(s, 4); s += __shfl_xor(s, 8);
        const float mu = s * (1.0f / 128.0f);
#pragma unroll
        for (int j = 0; j < 8; ++j) o[j] -= mu; }
    float q = 0.f;
#pragma unroll
    for (int j = 0; j < 8; ++j) q += o[j] * o[j];
    q += __shfl_xor(q, 1); q += __shfl_xor(q, 2); q += __shfl_xor(q, 4); q += __shfl_xor(q, 8);
    const float rs = 1.0f / sqrtf(q * (1.0f / 128.0f) + LN_EPS);
    float y[8];
#pragma unroll
    for (int j = 0; j < 8; ++j) { const float wn = isA ? (j < 4 ? nw0[j & 3] : nw1[j & 3]) : 1.0f; y[j] = o[j] * rs * wn * gt[j] * sigmoidf_(gt[j]); }
    u32x4 w; w.x = cvt_pk_bf16(y[0], y[1]); w.y = cvt_pk_bf16(y[2], y[3]); w.z = cvt_pk_bf16(y[4], y[5]); w.w = cvt_pk_bf16(y[6], y[7]);
    *(u32x4*)pg = w;
}
__device__ __forceinline__ void phase_comb(const Params& p, int l, int row_lo, int nrows, int nb, int bi) {
    int tid_ = threadIdx.x; asm volatile("" : "+v"(tid_));
    const int tid = tid_, sub = tid & 15;
    const f32x4 nw0 = *(const f32x4*)(p.a_norm_w + l * 128 + sub * 8), nw1 = *(const f32x4*)(p.a_norm_w + l * 128 + sub * 8 + 4);
    const int ngrp = nb * 32, total = (row_lo + nrows) * 16;
    for (int u = row_lo * 16 + ((bi * 512 + tid) >> 4); u < total; u += 4 * ngrp) {
        CombIn in[4]; bf16_t* pg[4];
#pragma unroll
        for (int k = 0; k < 4; ++k) { const int uu = (u + k * ngrp < total) ? u + k * ngrp : u; const bf16_t* pf; const bf16_t* pb; comb_ptrs(p, uu, sub, pf, pb, pg[k]);
            in[k].a = __builtin_nontemporal_load((const u32x4*)pf); in[k].b = __builtin_nontemporal_load((const u32x4*)pb); in[k].g = __builtin_nontemporal_load((const u32x4*)pg[k]); }
#pragma unroll
        for (int k = 0; k < 4; ++k) if (u + k * ngrp < total) comb_unit(in[k], (u & 15) < 8, nw0, nw1, pg[k]);
    }
}

__device__ __forceinline__ bf16x8 ldfrag(const LAS unsigned char* base, int pitch, int tile, int ks, int fr, int fq) {
    return *(const LAS bf16x8*)(base + (tile * 16 + fr) * pitch + (ks * 32 + fq * 8) * 2);
}
#define LDS_BARRIER() do { asm volatile("s_waitcnt lgkmcnt(0)" ::: "memory"); __builtin_amdgcn_s_barrier(); asm volatile("" ::: "memory"); } while (0)
#define MFMA16(a, b, c) __builtin_amdgcn_mfma_f32_16x16x32_bf16((a), (b), (c), 0, 0, 0)

constexpr int MIX_LDS_MAX = 139264;
template <int DK, bool IS_A, int NDV>
__device__ __forceinline__ void mix_stream(const Params& p, LAS unsigned char* lds, int l, int rs, int T, int h, int dir, int dvh) {
    constexpr int QP = (DK + 8) * 2, TP = 144, KS = DK / 32;
    static_assert(NDV == 8, "tile ownership below is written for all 128 value channels");
    constexpr int DVW = IS_A ? 4 : 2;
    constexpr int NTV = 2 * DVW, NO = NDV / 2;
    constexpr int OFF_Q = 0, OFF_K = OFF_Q + 64 * QP, OFF_VT = OFF_K + 64 * QP, OFF_KT = OFF_VT + 128 * TP, OFF_ST = OFF_KT + DK * TP, OFF_P = OFF_ST + 128 * QP,
                  OFF_SEG = OFF_P + 64 * TP, OFF_CDEC = OFF_SEG + 8 * DK * 4, OFF_CSC = OFF_CDEC + DK * 4, OFF_O = OFF_CSC + DK * 4, OP = 272;
    static_assert(OFF_O + 64 * OP <= MIX_LDS_MAX, "mixer LDS");
    int tid_ = threadIdx.x; asm volatile("" : "+v"(tid_));
    const int tid = tid_, lane = tid & 63, w = __builtin_amdgcn_readfirstlane(tid >> 6), fr = lane & 15, fq = lane >> 4, cp = lane, sg = w;
    const int gx = ((fr + 4) >> 3) & 1, fqx = fq ^ gx, gk = ((((2 * cp) & 15) + 4) >> 3) & 1, sgx = (sg & 1) << 4;
    LAS unsigned char* Qs = lds + OFF_Q; LAS unsigned char* Ks = lds + OFF_K; LAS unsigned char* Vt = lds + OFF_VT; LAS unsigned char* Kt = lds + OFF_KT;
    LAS unsigned char* St = lds + OFF_ST; LAS unsigned char* Ps = lds + OFF_P; LAS unsigned char* Os = lds + OFF_O;
    LAS float* seg = (LAS float*)(lds + OFF_SEG); LAS float* cdec = (LAS float*)(lds + OFF_CDEC); LAS float* csc = (LAS float*)(lds + OFF_CSC);
    const bf16_t* proj = (const bf16_t*)(p.ws + WS_PROJ);
    const int N = T >> 6;
    const int cq = IS_A ? (C_AQ + h * 128) : (C_RQ + h * 64);
    const int cf = IS_A ? ((dir ? C_AFB : C_AFF) + h * 128) : (C_RK + h * 64);
    const int cv = (IS_A ? (C_AI + h * 128) : (C_RV + h * 128)) + dvh * 64;
    bf16_t* obase; int opitch, ocol;
    if (IS_A) { obase = (bf16_t*)(p.ws + WS_PROJ); opitch = NC1; ocol = (dir ? C_AFB : C_AFF) + h * 128 + dvh * 64; }
    else { obase = (bf16_t*)(p.ws + (dir ? WS_OB : WS_U)); opitch = 1024; ocol = h * 128 + dvh * 64; }
    float lg = 0.f;
    if (!IS_A) { const float x = p.ret_decay[l * 16 + dir * 8 + h]; lg = -log1pf(expf(-x)); }
    const int tdk0 = IS_A ? 2 * (w & 3) : 2 * (w & 1), tdv0 = IS_A ? (w >> 2) * 4 : (w >> 1) * 2;

    f32x4 S[NTV], U[NTV];
#pragma unroll
    for (int i = 0; i < NTV; ++i) { S[i] = (f32x4){0.f, 0.f, 0.f, 0.f}; U[i] = (f32x4){0.f, 0.f, 0.f, 0.f}; }
    unsigned rq[2][8], rv[2][8], rf[2][8];
    unsigned vo[8];
#pragma unroll
    for (int i = 0; i < 8; ++i) { const int t = sg * 8 + i; vo[i] = (unsigned)((dir ? 63 - t : t) * (NC1 * 2)); }
    const unsigned cqk_b = IS_A ? (unsigned)(cq * 2 + 4 * cp) : (unsigned)((cp < 32 ? cq : cf) * 2 + 4 * (cp & 31));
    const unsigned cf_b = (unsigned)(cf * 2 + 4 * cp), cv_b = (unsigned)(cv * 2 + 4 * cp);
#define MIX_RB(nn) (rs + (dir ? T - 64 - (nn) * 64 : (nn) * 64))
#define MIX_LOAD(nn, pp) do { const char* cb = (const char*)proj + (size_t)MIX_RB(nn) * (NC1 * 2); \
        _Pragma("unroll") for (int i = 0; i < 8; ++i) { \
        rq[pp][i] = *(const unsigned*)(cb + (vo[i] + cqk_b)); \
        if (IS_A) rf[pp][i] = *(const unsigned*)(cb + (vo[i] + cf_b)); \
        if (NDV == 8 || cp < 32) rv[pp][i] = *(const unsigned*)(cb + (vo[i] + cv_b)); } } while (0)
    const unsigned fo = (unsigned)((dir ? 63 - (tid >> 3) : (tid >> 3)) * opitch * 2 + (ocol + (tid & 7) * (NDV == 8 ? 16 : 8)) * 2);
#define MIX_FLUSH(nn) do { char* ob_ = (char*)obase + (size_t)MIX_RB(nn) * (opitch * 2) + fo; \
        if (NDV == 8) { const LAS unsigned char* src = Os + (tid >> 3) * OP + (tid & 7) * 32; \
            const u32x4 v0 = *(const LAS u32x4*)src, v1 = *(const LAS u32x4*)(src + 16); *(u32x4*)ob_ = v0; *(u32x4*)(ob_ + 16) = v1; } \
        else { const LAS unsigned char* src = Os + (tid >> 3) * OP + (tid & 7) * 16; const u32x4 v0 = *(const LAS u32x4*)src; *(u32x4*)ob_ = v0; } } while (0)
    MIX_LOAD(0, 0);
    for (int n = 0; n < N; ++n) { constexpr int par = 0;
        if (IS_A) {
            float run0 = 0.f, run1 = 0.f;
#pragma unroll
            for (int i = 0; i < 8; ++i) { run0 += bf_lo(rf[par][i]); run1 += bf_hi(rf[par][i]); }
            *(LAS f32x2*)(seg + sg * DK + 2 * cp) = (f32x2){run0, run1};
        }
        LDS_BARRIER();
        if (n > 0) MIX_FLUSH(n - 1);
        {
            unsigned kt0[4], kt1[4], vt0[4], vt1[4];
            if (IS_A) {
                float pre0 = 0.f, pre1 = 0.f, ref0 = 0.f, ref1 = 0.f, tot0 = 0.f, tot1 = 0.f;
#pragma unroll
                for (int s8 = 0; s8 < 8; ++s8) { const f32x2 v = *(const LAS f32x2*)(seg + s8 * DK + 2 * cp);
                    if (s8 < sg) { pre0 += v.x; pre1 += v.y; } if (s8 < 4) { ref0 += v.x; ref1 += v.y; } tot0 += v.x; tot1 += v.y; }
                f32x2 E = (f32x2){exp2_(fminf(fmaxf(pre0 - ref0, -115.f), 115.f)), exp2_(fminf(fmaxf(pre1 - ref1, -115.f), 115.f))};
#pragma unroll
                for (int ip = 0; ip < 4; ++ip) { unsigned kp[2];
#pragma unroll
                    for (int e = 0; e < 2; ++e) { const int i = 2 * ip + e;
                        const f32x2 f = (f32x2){exp2_(bf_lo(rf[par][i])), exp2_(bf_hi(rf[par][i]))};
                        E = __builtin_elementwise_max(E * f, (f32x2){1e-35f, 1e-35f});
                        const f32x2 r = (f32x2){rcp_(E.x), rcp_(E.y)};
                        const f32x2 k = r - f * r;
                        const f32x2 qv = (f32x2){bf_lo(rq[par][i]), bf_hi(rq[par][i])} * E;
                        const int t = sg * 8 + i;
                        const int cb4 = (4 * cp) ^ ((i >= 4 ? 16 : 0) ^ sgx);
                        *(LAS unsigned*)(Qs + t * QP + cb4) = cvt_pk_bf16(qv.x, qv.y);
                        kp[e] = cvt_pk_bf16(k.x, k.y);
                        *(LAS unsigned*)(Ks + t * QP + cb4) = kp[e]; }
                    kt0[ip] = __builtin_amdgcn_perm(kp[1], kp[0], 0x05040100u); kt1[ip] = __builtin_amdgcn_perm(kp[1], kp[0], 0x07060302u);
                    vt0[ip] = __builtin_amdgcn_perm(rv[par][2 * ip + 1], rv[par][2 * ip], 0x05040100u); vt1[ip] = __builtin_amdgcn_perm(rv[par][2 * ip + 1], rv[par][2 * ip], 0x07060302u);
                }
                if (sg == 0) { *(LAS f32x2*)(cdec + 2 * cp) = (f32x2){exp2_(fmaxf(tot0, -115.f)), exp2_(fmaxf(tot1, -115.f))};
                               *(LAS f32x2*)(csc + 2 * cp) = (f32x2){exp2_(fmaxf(tot0 - ref0, -115.f)), exp2_(fmaxf(tot1 - ref1, -115.f))}; }
                *(LAS u32x4*)(Kt + (2 * cp) * TP + ((sg * 16) ^ (gk << 4))) = (u32x4){kt0[0], kt0[1], kt0[2], kt0[3]};
                *(LAS u32x4*)(Kt + (2 * cp + 1) * TP + ((sg * 16) ^ (gk << 4))) = (u32x4){kt1[0], kt1[1], kt1[2], kt1[3]};
            } else {
                const int ci = cp & 31;
#pragma unroll
                for (int ip = 0; ip < 4; ++ip) { unsigned kp[2];
#pragma unroll
                    for (int e = 0; e < 2; ++e) { const int i = 2 * ip + e; const int t = sg * 8 + i;
                        const float dd = (float)(t - 31) * lg;
                        const float sc = __expf(cp < 32 ? dd : -dd);
                        kp[e] = cvt_pk_bf16(bf_lo(rq[par][i]) * sc, bf_hi(rq[par][i]) * sc);
                        *(LAS unsigned*)((cp < 32 ? Qs : Ks) + t * QP + ((4 * ci) ^ ((i >= 4 ? 16 : 0) ^ sgx))) = kp[e]; }
                    kt0[ip] = __builtin_amdgcn_perm(kp[1], kp[0], 0x05040100u); kt1[ip] = __builtin_amdgcn_perm(kp[1], kp[0], 0x07060302u);
                    vt0[ip] = __builtin_amdgcn_perm(rv[par][2 * ip + 1], rv[par][2 * ip], 0x05040100u); vt1[ip] = __builtin_amdgcn_perm(rv[par][2 * ip + 1], rv[par][2 * ip], 0x07060302u);
                }
                if (cp >= 32) { *(LAS u32x4*)(Kt + (2 * ci) * TP + ((sg * 16) ^ (gk << 4))) = (u32x4){kt0[0], kt0[1], kt0[2], kt0[3]};
                                *(LAS u32x4*)(Kt + (2 * ci + 1) * TP + ((sg * 16) ^ (gk << 4))) = (u32x4){kt1[0], kt1[1], kt1[2], kt1[3]}; }
            }
            if (NDV == 8 || cp < 32) {
            *(LAS u32x4*)(Vt + (2 * cp) * TP + ((sg * 16) ^ (gk << 4))) = (u32x4){vt0[0], vt0[1], vt0[2], vt0[3]};
            *(LAS u32x4*)(Vt + (2 * cp + 1) * TP + ((sg * 16) ^ (gk << 4))) = (u32x4){vt1[0], vt1[1], vt1[2], vt1[3]}; }
        }
#pragma unroll
        for (int dki = 0; dki < 2; ++dki) { f32x4 er;
          if (IS_A) { const int dk = (tdk0 + dki) * 16 + fq * 4; const f32x4 e = *(const LAS f32x4*)(seg + dk) + *(const LAS f32x4*)(seg + DK + dk) + *(const LAS f32x4*)(seg + 2 * DK + dk) + *(const LAS f32x4*)(seg + 3 * DK + dk);
#pragma unroll
              for (int j = 0; j < 4; ++j) er[j] = exp2_(fmaxf(e[j], -115.f)); }
          else { const float e = __expf(32.0f * lg); er = (f32x4){e, e, e, e}; }
#pragma unroll
          for (int dvi = 0; dvi < DVW; ++dvi) { const f32x4 sv = S[dki * DVW + dvi] * er; u32x2 pk; pk.x = cvt_pk_bf16(sv[0], sv[1]); pk.y = cvt_pk_bf16(sv[2], sv[3]);
              *(LAS u32x2*)(St + ((tdv0 + dvi) * 16 + fr) * QP + ((((tdk0 + dki) * 16 + fq * 4) * 2) ^ (gx << 4))) = pk; } }
        if (n + 1 < N) MIX_LOAD(n + 1, par);
        LDS_BARRIER();
        { const int tt = w >> 1, ts0 = (w & 1) * 2; f32x4 pa = (f32x4){0.f, 0.f, 0.f, 0.f}, pb = pa;
          bf16x8 gq_[KS], gk0[KS], gk1[KS];
#pragma unroll
          for (int ks = 0; ks < KS; ++ks) { gq_[ks] = ldfrag(Qs, QP, tt, ks, fr, fqx); gk0[ks] = ldfrag(Ks, QP, ts0, ks, fr, fqx); gk1[ks] = ldfrag(Ks, QP, ts0 + 1, ks, fr, fqx); }
          __builtin_amdgcn_sched_barrier(0);
#pragma unroll
          for (int ks = 0; ks < KS; ++ks) { pa = MFMA16(gk0[ks], gq_[ks], pa); pb = MFMA16(gk1[ks], gq_[ks], pb); }
          const int t = tt * 16 + fr, s0 = ts0 * 16 + fq * 4, s1 = s0 + 16;
          u32x2 w0, w1;
          w0.x = cvt_pk_bf16(t >= s0 ? pa[0] : 0.f, t >= s0 + 1 ? pa[1] : 0.f); w0.y = cvt_pk_bf16(t >= s0 + 2 ? pa[2] : 0.f, t >= s0 + 3 ? pa[3] : 0.f);
          w1.x = cvt_pk_bf16(t >= s1 ? pb[0] : 0.f, t >= s1 + 1 ? pb[1] : 0.f); w1.y = cvt_pk_bf16(t >= s1 + 2 ? pb[2] : 0.f, t >= s1 + 3 ? pb[3] : 0.f);
          *(LAS u32x2*)(Ps + t * TP + ((s0 * 2) ^ (gx << 4))) = w0; *(LAS u32x2*)(Ps + t * TP + ((s1 * 2) ^ (gx << 4))) = w1; }
#pragma unroll
        for (int ks = 0; ks < 2; ++ks) { bf16x8 ak[2], bv[DVW];
#pragma unroll
            for (int dki = 0; dki < 2; ++dki) ak[dki] = ldfrag(Kt, TP, tdk0 + dki, ks, fr, fqx);
#pragma unroll
            for (int dvi = 0; dvi < DVW; ++dvi) bv[dvi] = ldfrag(Vt, TP, tdv0 + dvi, ks, fr, fqx);
            __builtin_amdgcn_sched_barrier(0);
#pragma unroll
            for (int dki = 0; dki < 2; ++dki)
#pragma unroll
                for (int dvi = 0; dvi < DVW; ++dvi) U[dki * DVW + dvi] = MFMA16(ak[dki], bv[dvi], U[dki * DVW + dvi]);
            __builtin_amdgcn_sched_barrier(0); }
        LDS_BARRIER();
        { const int tp = w >> 2, dp = w & 3; f32x4 o[4];
#pragma unroll
          for (int q = 0; q < 4; ++q) o[q] = (f32x4){0.f, 0.f, 0.f, 0.f};
#pragma unroll
          for (int kb = 0; kb < KS; kb += 2) { bf16x8 b[2][2], a[2][2];
#pragma unroll
              for (int k2 = 0; k2 < 2; ++k2)
#pragma unroll
                  for (int i2 = 0; i2 < 2; ++i2) { b[k2][i2] = ldfrag(Qs, QP, 2 * tp + i2, kb + k2, fr, fqx); a[k2][i2] = ldfrag(St, QP, 2 * dp + i2, kb + k2, fr, fqx); }
              __builtin_amdgcn_sched_barrier(0);
#pragma unroll
              for (int k2 = 0; k2 < 2; ++k2)
#pragma unroll
                  for (int ti = 0; ti < 2; ++ti)
#pragma unroll
                      for (int di = 0; di < 2; ++di) o[ti * 2 + di] = MFMA16(a[k2][di], b[k2][ti], o[ti * 2 + di]);
              __builtin_amdgcn_sched_barrier(0); }
          { bf16x8 b[2][2], a[2][2];
#pragma unroll
              for (int k2 = 0; k2 < 2; ++k2)
#pragma unroll
                  for (int i2 = 0; i2 < 2; ++i2) { b[k2][i2] = ldfrag(Ps, TP, 2 * tp + i2, k2, fr, fqx); a[k2][i2] = ldfrag(Vt, TP, 2 * dp + i2, k2, fr, fqx); }
              __builtin_amdgcn_sched_barrier(0);
#pragma unroll
              for (int k2 = 0; k2 < 2; ++k2)
#pragma unroll
                  for (int ti = 0; ti < 2; ++ti)
#pragma unroll
                      for (int di = 0; di < 2; ++di) o[ti * 2 + di] = MFMA16(a[k2][di], b[k2][ti], o[ti * 2 + di]);
              __builtin_amdgcn_sched_barrier(0); }
#pragma unroll
          for (int ti = 0; ti < 2; ++ti)
#pragma unroll
              for (int di = 0; di < 2; ++di) { const f32x4 ov = o[ti * 2 + di]; u32x2 pk; pk.x = cvt_pk_bf16(ov[0], ov[1]); pk.y = cvt_pk_bf16(ov[2], ov[3]);
                  *(LAS u32x2*)(Os + ((2 * tp + ti) * 16 + fr) * OP + ((2 * dp + di) * 16 + fq * 4) * 2) = pk; } }
#pragma unroll
        for (int dki = 0; dki < 2; ++dki) { f32x4 cd, cs;
          if (IS_A) { cd = *(const LAS f32x4*)(cdec + (tdk0 + dki) * 16 + fq * 4); cs = *(const LAS f32x4*)(csc + (tdk0 + dki) * 16 + fq * 4); }
          else { const float a = __expf(64.0f * lg), b = __expf(32.0f * lg); cd = (f32x4){a, a, a, a}; cs = (f32x4){b, b, b, b}; }
#pragma unroll
          for (int dvi = 0; dvi < DVW; ++dvi) { S[dki * DVW + dvi] = S[dki * DVW + dvi] * cd + U[dki * DVW + dvi] * cs; U[dki * DVW + dvi] = (f32x4){0.f, 0.f, 0.f, 0.f}; } }
    }
    __syncthreads();
    MIX_FLUSH(N - 1);
    __syncthreads();
#undef MIX_LOAD
#undef MIX_FLUSH
#undef MIX_RB
}

__device__ __forceinline__ void phase_mix(const Params& p, LAS unsigned char* lds, int l, int g) {
    const int G = gridDim.x, b = blockIdx.x;
    const int nstreams = g == 0 ? 256 : 320;
    for (int r = 0; r * G < nstreams; ++r) {
        const int bi = (r & 1) ? (G - 1 - b) : b; const int sidx = r * G + bi;
        if (sidx >= nstreams) continue;
        bool isA; int q, rs, T;
        if (g == 0) {
            if (sidx < 64) { isA = sidx < 32; q = sidx & 31; rs = (q >> 4) * 8192; T = 8192; }
            else { isA = sidx < 160; q = isA ? sidx - 64 : sidx - 160; rs = 16384 + (q >> 4) * 4096; T = 4096; }
        } else { isA = sidx < 160; q = isA ? sidx : sidx - 160; rs = (q >> 4) * 4096; T = 4096; }
        const int h = (q >> 1) & 7, dir = q & 1;
        if (isA) mix_stream<128, true, 8>(p, lds, l, rs, T, h, dir, 0); else mix_stream<64, false, 8>(p, lds, l, rs, T, h, dir, 0);
    }
}

constexpr int N_PHASES = 3 + 6 * 4;
constexpr int LDS_BYTES = MIX_LDS_MAX + 16;

__global__ void __launch_bounds__(512, 2) fwd_megakernel(Params p) {
    extern __shared__ __attribute__((aligned(16))) unsigned char lds_raw[];
    LAS unsigned char* lds = (LAS unsigned char*)lds_raw;
    cg::grid_group grid = cg::this_grid();
    if (threadIdx.x < 4) ((LAS unsigned*)(lds + MIX_LDS_MAX))[threadIdx.x] = 0u;
    __syncthreads();
    XcdBarrier xbar = xcd_barrier_post((unsigned*)(p.ws + WS_BAR), (volatile LAS unsigned*)(lds + MIX_LDS_MAX));
    const int G = gridDim.x, bid = blockIdx.x;
    bf16_t* proj = (bf16_t*)(p.ws + WS_PROJ); bf16_t* ubuf = (bf16_t*)(p.ws + WS_U);
    for (int ph = p.ph_lo; ph < p.ph_hi; ++ph) {
        if (ph == 0) phase_init(p, lds);
        else if (ph == 1) phase_ada_fin(p);
        else if (ph == 2) phase_prep(p, 0, 0);
        else {
            const int idx = (ph - 3) / 6, sub = (ph - 3) % 6, g = idx >> 1, l = idx & 1;
            const bool ovl = (G == 256) && (g == 0);
            bool extra = false;
            if (sub == 1) {
                phase_mix(p, lds, l, g);
                if (ovl && bid >= 64) {
                    unsigned* sb = (unsigned*)(p.ws + WS_BAR) + 3520 + l * 128;
                    subset_barrier(sb, 192u);
                    phase_comb(p, l, 16384, MG - 16384, 192, bid - 64);
                    subset_barrier(sb + 64, 192u);
                    extra = true;
                }
            }
            else if (sub == 2) { if (ovl) phase_comb(p, l, 0, 16384, G, bid); else phase_comb(p, l, 0, MG, G, bid); }
            if (sub == 0 || sub == 3 || sub == 4 || extra) {
                pg8::Gemm gm; EpiAll E; pg8::StaticOrder S;
                E.lbp = p.hgrn_lb; E.rope = (const float2*)(p.ws + WS_ROPE); E.proj = proj; E.xp = p.x_prompt; E.xs = p.x_sample; E.out = p.out; E.g = g; E.layer = l;
                if (sub == 0)      { gm = pg8::Gemm{ubuf, (const bf16_t*)(p.ws + WS_WT1) + (size_t)l * 10240 * 1024, MG, NC1, 1024, 1024, 1024, nullptr, nullptr}; E.mode = 0; E.O = proj; E.bias = p.b_mg + l * 2048; S.init(MG, NC1, G, bid); }
                else if (sub == 4) { gm = pg8::Gemm{ubuf, (const bf16_t*)(p.ws + WS_WOUT) + (size_t)l * 1024 * 1024, MG, 1024, 1024, 1024, 1024, nullptr, nullptr}; E.mode = 3; E.O = ubuf; E.bias = (const float*)(p.ws + WS_ADA) + l * 18 * 3072; S.init(MG, 1024, G, bid); }
                else { gm = pg8::Gemm{proj + C_AG, (const bf16_t*)(p.ws + WS_WPA) + (size_t)l * 1024 * 1024, MG, 1024, 1024, NC1, 1024, proj + C_RG, (const bf16_t*)(p.ws + WS_WPB) + (size_t)l * 1024 * 1024}; E.mode = 1; E.O = ubuf; E.bias = nullptr;
                    if (extra) S.init(MG - 16384, 1024, 192, bid - 64, 64); else if (ovl) S.init(16384, 1024, G, bid); else S.init(MG, 1024, G, bid); }
                pg8::gemm_phase<EpiAll>(lds, gm, S, E);
            }
            if (sub == 5) {
                phase_ln(p, l, g, l == 0);
                if (l == 1 && g == 0) phase_prep(p, 0, 1);
            }
        }
        if (ph + 1 < p.ph_hi) { if (ph == 0) grid.sync(); else xcd_barrier(xbar); }
    }
}

#ifndef ONE_LAUNCH
#define ONE_LAUNCH 1
#endif
extern "C" void kernel_launch(void* const* d_in, const int* in_sizes, int n_in, void* d_out, int out_size, void* d_ws, size_t ws_size, hipStream_t stream) {
    static int grid = 0;
    if (grid == 0) {
        if (n_in != 17 || out_size != NTOK * D || ws_size < WS_END) { fprintf(stderr, "kernel_launch: unexpected shapes / workspace (n_in %d out %d ws %zu need %zu)\n", n_in, out_size, ws_size, (size_t)WS_END); grid = -1; return; }
        int dev = 0, cus = 0, per_cu = 0;
        hipGetDevice(&dev); hipDeviceGetAttribute(&cus, hipDeviceAttributeMultiprocessorCount, dev);
        if (hipFuncSetAttribute((const void*)fwd_megakernel, hipFuncAttributeMaxDynamicSharedMemorySize, LDS_BYTES) != hipSuccess) { fprintf(stderr, "kernel_launch: hipFuncSetAttribute failed\n"); grid = -1; return; }
        if (hipOccupancyMaxActiveBlocksPerMultiprocessor(&per_cu, (const void*)fwd_megakernel, 512, LDS_BYTES) != hipSuccess || per_cu < 1) { fprintf(stderr, "kernel_launch: occupancy query says %d\n", per_cu); per_cu = 1; }
        (void)hipGetLastError();
        grid = cus;
    }
    if (grid < 0) return;
    if (hipMemsetAsync((char*)d_ws + WS_BAR, 0, 16384, stream) != hipSuccess) { fprintf(stderr, "kernel_launch: memset of the barrier words failed\n"); return; }
    Params p{};
    p.x_prompt = (const float*)d_in[0]; p.x_sample = (const float*)d_in[1]; p.c_prompt = (const float*)d_in[2]; p.c_sample = (const float*)d_in[3];
    p.w_ada = (const float*)d_in[4]; p.b_ada = (const float*)d_in[5]; p.w_in = (const float*)d_in[6]; p.hgrn_lb = (const float*)d_in[7]; p.a_norm_w = (const float*)d_in[8];
    p.ret_decay = (const float*)d_in[9]; p.w_pa = (const float*)d_in[10]; p.w_pb = (const float*)d_in[11]; p.w_mg = (const float*)d_in[12]; p.b_mg = (const float*)d_in[13];
    p.w_out = (const float*)d_in[14]; p.ln_g = (const float*)d_in[15]; p.ln_b = (const float*)d_in[16];
    p.out = (float*)d_out; p.ws = (unsigned char*)d_ws;
#if ONE_LAUNCH
    p.ph_lo = 0; p.ph_hi = N_PHASES;
    void* args[] = {&p};
    hipError_t e = hipLaunchCooperativeKernel((const void*)fwd_megakernel, dim3(grid), dim3(512), args, LDS_BYTES, stream);
    if (e != hipSuccess) fprintf(stderr, "cooperative launch failed: %s (grid %d)\n", hipGetErrorString(e), grid);
#else
    for (int ph = 0; ph < N_PHASES; ++ph) { p.ph_lo = ph; p.ph_hi = ph + 1; hipLaunchKernelGGL(fwd_megakernel, dim3(grid), dim3(512), LDS_BYTES, stream, p); }
#endif
}
```

```cpp
#include <hip/hip_runtime.h>
#include <hip/hip_cooperative_groups.h>
#include <cstdio>
#include <cmath>
namespace cg = cooperative_groups;

#define LAS __attribute__((address_space(3)))
typedef unsigned short bf16_t;
typedef short bf16x8 __attribute__((ext_vector_type(8)));
typedef float f32x4 __attribute__((ext_vector_type(4)));
typedef unsigned u32x4 __attribute__((ext_vector_type(4)));
typedef unsigned u32x2 __attribute__((ext_vector_type(2)));
typedef float f32x2 __attribute__((ext_vector_type(2)));

constexpr int D = 1024, NTOK = 81920, NPTOK = 65536, NSEQ = 18, MG = 40960, NC1 = 10240;
constexpr int C_AQ = 0, C_AFF = 1024, C_AFB = 2048, C_AI = 3072, C_AG = 4096, C_RQ = 5120, C_RK = 5632, C_RV = 6144, C_RG = 7168, C_MG = 8192;
constexpr float LN_EPS = 1e-5f;
constexpr float DN_ALPHA = 1.41421356237309515f;

constexpr size_t WS_BAR = 0;
constexpr size_t WS_WT1 = 16384;
constexpr size_t WS_WPA = WS_WT1 + (size_t)2 * 10240 * 1024 * 2;
constexpr size_t WS_WPB = WS_WPA + (size_t)2 * 1024 * 1024 * 2;
constexpr size_t WS_WOUT = WS_WPB + (size_t)2 * 1024 * 1024 * 2;
constexpr size_t WS_ADA = WS_WOUT + (size_t)2 * 1024 * 1024 * 2;
constexpr size_t WS_ROPE = WS_ADA + (size_t)2 * 18 * 3072 * 4;
constexpr size_t WS_U = WS_ROPE + (size_t)8192 * 32 * 8;
constexpr size_t WS_OB = WS_U + (size_t)MG * 1024 * 2;
constexpr size_t WS_PROJ = WS_OB + (size_t)MG * 1024 * 2;
constexpr size_t WS_END = WS_PROJ + (size_t)MG * NC1 * 2;

struct Params {
    const float* x_prompt; const float* x_sample; const float* c_prompt; const float* c_sample;
    const float* w_ada; const float* b_ada; const float* w_in; const float* hgrn_lb; const float* a_norm_w; const float* ret_decay;
    const float* w_pa; const float* w_pb; const float* w_mg; const float* b_mg; const float* w_out; const float* ln_g; const float* ln_b;
    float* out; unsigned char* ws;
    int ph_lo, ph_hi;
};

__device__ __forceinline__ int grow(int g, int r) { return g == 0 ? (r < 16384 ? 65536 + r : r - 16384) : 24576 + r; }
__device__ __forceinline__ int seq_of(int gr) { return gr < 65536 ? (gr >> 12) : 16 + ((gr - 65536) >> 13); }
__device__ __forceinline__ unsigned cvt_pk_bf16(float lo, float hi) { unsigned r; asm("v_cvt_pk_bf16_f32 %0, %1, %2" : "=v"(r) : "v"(lo), "v"(hi)); return r; }
__device__ __forceinline__ bf16_t f2bf(float f) { return (bf16_t)(cvt_pk_bf16(f, 0.f) & 0xffffu); }
__device__ __forceinline__ float bf_lo(unsigned u) { return __uint_as_float(u << 16); }
__device__ __forceinline__ float bf_hi(unsigned u) { return __uint_as_float(u & 0xffff0000u); }
__device__ __forceinline__ float bf2f(bf16_t b) { return __uint_as_float(((unsigned)b) << 16); }
__device__ __forceinline__ float rcp_(float x) { return __builtin_amdgcn_rcpf(x); }
__device__ __forceinline__ float exp2_(float x) { return __builtin_amdgcn_exp2f(x); }
__device__ __forceinline__ float sigmoidf_(float x) { return rcp_(1.0f + exp2_(-1.4426950408889634f * x)); }

namespace pg8 {
constexpr int BM = 256, BK = 64, HALF = 128, HTB = HALF * BK * 2  , STAGE_BYTES = 8 * HTB, NXCD = 8, WGM = 8;
__host__ __device__ __forceinline__ int lds_byte(int r, int c) { const int st = (r >> 4) * 2 + (c >> 5), rr = r & 15, cc = c & 31, ob = rr * 64 + cc * 2; return st * 1024 + (ob ^ (((ob >> 9) & 1) << 5)); }
__host__ __device__ __forceinline__ void stage_rc(int b, int& R, int& C) { const int st = b / 1024, sb = b % 1024, swz = sb ^ (((sb >> 9) & 1) << 5); R = (st >> 1) * 16 + swz / 64; C = (st & 1) * 32 + (swz % 64) / 2; }
__host__ __device__ __forceinline__ int perm32(int rho) { const int n = rho >> 4, i = rho & 15; return 8 * (i >> 2) + 4 * n + (i & 3); }

struct Unit { int pm, pn; };
struct Gemm { const bf16_t* A; const bf16_t* Bt; int M, N, K, lda, ldb; const bf16_t* A2; const bf16_t* Bt2; };

struct StaticOrder {
    int nM, nN, nwg, G, c, pm0;
    __host__ __device__ void init(int M, int N, int G_, int c_, int pm0_ = 0) { nM = M / BM; nN = N / BM; nwg = nM * nN; G = G_; c = c_; pm0 = pm0_; }
    __host__ __device__ bool next(int i, Unit& u) const {
        const long L = (long)i * G + c; if (L >= nwg) return false;
        int wgid = (int)L; { const int q = nwg / NXCD, r = nwg % NXCD, xcd = wgid % NXCD, off = wgid / NXCD; wgid = (xcd < r ? xcd * (q + 1) : r * (q + 1) + (xcd - r) * q) + off; }
        const int nig = WGM * nN, gid = wgid / nig, fm = gid * WGM, gsz = (nM - fm) < WGM ? (nM - fm) : WGM;
        u.pm = pm0 + fm + ((wgid % nig) % gsz); u.pn = (wgid % nig) / gsz; return true;
    }
};

template <class Epi>
__device__ __forceinline__ void gemm_phase(LAS unsigned char* lds, const Gemm g, const StaticOrder& S, const Epi& E) {
    int tid_ = threadIdx.x; asm volatile("" : "+v"(tid_));
    const int tid = tid_, wid = __builtin_amdgcn_readfirstlane(tid >> 6), lane = tid & 63, wr = wid >> 2, wc = wid & 3, fr = lane & 15, fq = lane >> 4;
    const int K = g.K, nt = K / BK, npass = g.A2 ? 2 : 1;
    unsigned voffA[2], voffB[2];
#pragma unroll
    for (int i = 0; i < 2; ++i) { int R, C; stage_rc(tid * 16 + i * 8192, R, C); const int Rb = Epi::PERM ? ((R & ~31) + perm32(R & 31)) : R;
        voffA[i] = (unsigned)(R * g.lda + C) * 2u; voffB[i] = (unsigned)(Rb * g.ldb + C) * 2u; }
    const size_t kstep = (size_t)(BK * 2);
    const size_t hstepA = (size_t)HALF * g.lda * 2, hstepB = (size_t)HALF * g.ldb * 2;
    const size_t tstepA = 2 * hstepA, tstepB = 2 * hstepB;
    const unsigned ldsw = (unsigned)wid * 1024u;
    const int aoff = lds_byte(wr * 64 + fr, fq * 8), boff = lds_byte(wc * 32 + fr, fq * 8);
#define PG8_SA(b, h) (((b) * 2 + (h)) * HTB)
#define PG8_SB(b, h) ((4 + (b) * 2 + (h)) * HTB)
#define PG8_STAGE(bufoff, gbase, voff) do { _Pragma("unroll") for (int _i = 0; _i < 2; ++_i) \
        __builtin_amdgcn_global_load_lds((const unsigned*)((const char*)(gbase) + (voff)[_i]), (LAS unsigned*)(lds + (bufoff) + ldsw + _i * 8192), 16, 0, 0); } while (0)
#define PG8_LDA(dst, b, h) do { _Pragma("unroll") for (int m = 0; m < 4; ++m) _Pragma("unroll") for (int k = 0; k < 2; ++k) dst[m][k] = *(const LAS bf16x8*)(lds + PG8_SA(b, h) + aoff + m * 2048 + k * 1024); } while (0)
#define PG8_LDB(dst, b, h) do { _Pragma("unroll") for (int n = 0; n < 2; ++n) _Pragma("unroll") for (int k = 0; k < 2; ++k) dst[n][k] = *(const LAS bf16x8*)(lds + PG8_SB(b, h) + boff + n * 2048 + k * 1024); } while (0)
#define PG8_MMA(ai, bj, At, Bt) do { __builtin_amdgcn_s_setprio(1); _Pragma("unroll") for (int m = 0; m < 4; ++m) _Pragma("unroll") for (int n = 0; n < 2; ++n) _Pragma("unroll") for (int k = 0; k < 2; ++k) \
        acc[ai][bj][m][n] = __builtin_amdgcn_mfma_f32_16x16x32_bf16(Bt[n][k], At[m][k], acc[ai][bj][m][n], 0, 0, 0); __builtin_amdgcn_s_setprio(0); } while (0)
#define PG8_WAIT_V(n) asm volatile("s_waitcnt vmcnt(" #n ")" ::: "memory")
#define PG8_WAIT_L(n) asm volatile("s_waitcnt lgkmcnt(" #n ")" ::: "memory")
#define PG8_BAR __builtin_amdgcn_s_barrier()
#define PG8_SCHED __builtin_amdgcn_sched_barrier(0)
    Unit cur, nxt; int ui = 0;
    if (!S.next(0, cur)) return;
    f32x4 acc[2][2][4][2];
#pragma unroll
    for (int a = 0; a < 2; ++a)
#pragma unroll
        for (int b = 0; b < 2; ++b)
#pragma unroll
            for (int m = 0; m < 4; ++m)
#pragma unroll
                for (int n = 0; n < 2; ++n) acc[a][b][m][n] = (f32x4){0.f, 0.f, 0.f, 0.f};
    bf16x8 At[4][2], B0[2][2], B1[2][2];
    const char* cA = (const char*)g.A + (size_t)cur.pm * tstepA; const char* cB = (const char*)g.Bt + (size_t)cur.pn * tstepB;
    PG8_STAGE(PG8_SB(0, 0), cB, voffB); PG8_STAGE(PG8_SA(0, 0), cA, voffA); PG8_STAGE(PG8_SB(0, 1), cB + hstepB, voffB); PG8_STAGE(PG8_SA(0, 1), cA + hstepA, voffA);
    if (wr == 1) PG8_BAR;
    PG8_WAIT_V(4); PG8_BAR;
    PG8_STAGE(PG8_SB(1, 0), cB + kstep, voffB); PG8_STAGE(PG8_SA(1, 0), cA + kstep, voffA); PG8_STAGE(PG8_SB(1, 1), cB + hstepB + kstep, voffB);
    PG8_WAIT_V(6); PG8_BAR;
    for (;;) {
        const bool has_next = S.next(ui + 1, nxt);
        const char* nA = cA; const char* nB = cB;
        for (int pass = 0; pass < npass; ++pass) {
        const bool lastpass = (pass == npass - 1);
        if (!lastpass) { nA = (const char*)g.A2 + (size_t)cur.pm * tstepA; nB = (const char*)g.Bt2 + (size_t)cur.pn * tstepB; }
        else if (has_next) { nA = (const char*)g.A + (size_t)nxt.pm * tstepA; nB = (const char*)g.Bt + (size_t)nxt.pn * tstepB; }
        else { nA = cA; nB = cB; }
        for (int t = 0; t < nt; t += 2) {
            const bool last = (t == nt - 2);
            const char* a1 = cA + (size_t)(t + 1) * kstep;
            const char* a2 = last ? nA : cA + (size_t)(t + 2) * kstep; const char* b2 = last ? nB : cB + (size_t)(t + 2) * kstep;
            const char* a3 = a2 + kstep; const char* b3 = b2 + kstep;
            PG8_LDB(B0, 0, 0); PG8_SCHED; PG8_LDA(At, 0, 0); PG8_STAGE(PG8_SA(1, 1), a1 + hstepA, voffA);
            PG8_WAIT_L(8); PG8_BAR; PG8_WAIT_L(0); PG8_MMA(0, 0, At, B0); PG8_BAR; PG8_SCHED;
            PG8_LDB(B1, 0, 1); PG8_STAGE(PG8_SB(0, 0), b2, voffB);
            PG8_BAR; PG8_WAIT_L(0); PG8_MMA(0, 1, At, B1); PG8_BAR;
            PG8_LDA(At, 0, 1); PG8_STAGE(PG8_SA(0, 0), a2, voffA);
            PG8_BAR; PG8_WAIT_L(0); PG8_MMA(1, 0, At, B0); PG8_BAR; PG8_SCHED;
            PG8_STAGE(PG8_SB(0, 1), b2 + hstepB, voffB);
            PG8_WAIT_V(6); PG8_BAR; PG8_MMA(1, 1, At, B1); PG8_BAR;
            PG8_LDB(B0, 1, 0); PG8_SCHED; PG8_LDA(At, 1, 0); PG8_STAGE(PG8_SA(0, 1), a2 + hstepA, voffA);
            PG8_WAIT_L(8); PG8_BAR; PG8_WAIT_L(0); PG8_MMA(0, 0, At, B0); PG8_BAR; PG8_SCHED;
            PG8_LDB(B1, 1, 1); PG8_STAGE(PG8_SB(1, 0), b3, voffB);
            PG8_BAR; PG8_WAIT_L(0); PG8_MMA(0, 1, At, B1); PG8_BAR;
            PG8_LDA(At, 1, 1); PG8_STAGE(PG8_SA(1, 0), a3, voffA);
            PG8_BAR; PG8_WAIT_L(0); PG8_MMA(1, 0, At, B0); PG8_BAR; PG8_SCHED;
            PG8_STAGE(PG8_SB(1, 1), b3 + hstepB, voffB);
            PG8_WAIT_V(6); PG8_BAR; PG8_MMA(1, 1, At, B1); PG8_BAR;
        }
        if (!lastpass) { E.mid(acc, cur, wr, wc, fr, fq); cA = nA; cB = nB; }
        }
        E(acc, cur, wr, wc, fr, fq);
        if (!has_next) break;
#pragma unroll
        for (int a = 0; a < 2; ++a)
#pragma unroll
            for (int b = 0; b < 2; ++b)
#pragma unroll
                for (int m = 0; m < 4; ++m)
#pragma unroll
                    for (int n = 0; n < 2; ++n) acc[a][b][m][n] = (f32x4){0.f, 0.f, 0.f, 0.f};
        cur = nxt; cA = nA; cB = nB; ++ui;
    }
    PG8_WAIT_V(0);
    if (wr == 0) PG8_BAR;
    PG8_BAR;
#undef PG8_SA
#undef PG8_SB
#undef PG8_STAGE
#undef PG8_LDA
#undef PG8_LDB
#undef PG8_MMA
#undef PG8_WAIT_V
#undef PG8_WAIT_L
#undef PG8_BAR
#undef PG8_SCHED
}
}

#define XB_TMO      128
#define XB_XCNT(j)  (256  + 64 * (j))
#define XB_XSUB(j)  (1280 + 64 * (j))
#define XB_XGEN(j)  (2304 + 64 * (j))
#define XB_TOP      3328
#define XB_TOPGEN   3392
#define XCD_BAR_WORDS 3456
#define XB_SPIN_CAP (1u << 18)

__device__ __forceinline__ unsigned xb_ld(unsigned* p)              { return __hip_atomic_load(p, __ATOMIC_RELAXED, __HIP_MEMORY_SCOPE_AGENT); }
__device__ __forceinline__ unsigned xb_add(unsigned* p, unsigned v) { return __hip_atomic_fetch_add(p, v, __ATOMIC_RELAXED, __HIP_MEMORY_SCOPE_AGENT); }
__device__ __forceinline__ unsigned xb_xcc_id() { return (unsigned)__builtin_amdgcn_s_getreg((3 << 11) | 20) & 0xFu; }
#define XB_SPIN(cond, bar) do { unsigned _sp = 0; while (cond) { __builtin_amdgcn_s_sleep(1); \
    if ((++_sp & 255u) == 0u) { if (xb_ld(&(bar)[XB_TMO])) break; if (_sp > XB_SPIN_CAP) { atomicAdd(&(bar)[XB_TMO], 1u); break; } } } } while (0)

struct XcdBarrier {
    unsigned* bar; unsigned x;
    volatile LAS unsigned* st;
};

__device__ __forceinline__ XcdBarrier xcd_barrier_post(unsigned* bar, volatile LAS unsigned* st) {
    XcdBarrier b; b.bar = bar; b.x = xb_xcc_id(); b.st = st;
    if (threadIdx.x == 0) (void)xb_add(&bar[XB_XCNT(b.x)], 1u);
    return b;
}
__device__ __forceinline__ void xcd_barrier_complete(unsigned* bar, unsigned x, unsigned& nloc, unsigned& nx) {
    const unsigned G = gridDim.x * gridDim.y * gridDim.z;
    unsigned sum, cnt, mine, sp = 0u;
    for (;;) {
        sum = 0u; cnt = 0u; mine = 0u;
#pragma unroll
        for (unsigned j = 0; j < 16; ++j) { const unsigned c = xb_ld(&bar[XB_XCNT(j)]); sum += c; cnt += (c > 0u) ? 1u : 0u; mine = (j == x) ? c : mine; }
        if (sum == G) break;
        __builtin_amdgcn_s_sleep(1);
        if ((++sp & 255u) == 0u) { if (xb_ld(&bar[XB_TMO])) break; if (sp > XB_SPIN_CAP) { atomicAdd(&bar[XB_TMO], 1u); break; } }
    }
    nloc = mine > 0u ? mine : 1u; nx = cnt > 0u ? cnt : 1u;
}

__device__ __forceinline__ void xcd_barrier(const XcdBarrier& b) {
    asm volatile("s_waitcnt vmcnt(0)" ::: "memory");
    __syncthreads();
    if (threadIdx.x == 0) {
        unsigned* bar = b.bar;
        __builtin_amdgcn_s_waitcnt(0);
        unsigned nloc = b.st[0], nx = b.st[1];
        if (nloc == 0u) { xcd_barrier_complete(bar, b.x, nloc, nx); b.st[0] = nloc; b.st[1] = nx; }
        const unsigned old = xb_add(&bar[XB_XSUB(b.x)], 1u);
        const unsigned gen = old / nloc;
        if (old + 1u == (gen + 1u) * nloc) {
            __builtin_amdgcn_fence(__ATOMIC_RELEASE, "agent");
            asm volatile("s_waitcnt vmcnt(0)" ::: "memory");
            const unsigned og = xb_add(&bar[XB_TOP], 1u);
            const unsigned tg = og / nx;
            if (og + 1u == (tg + 1u) * nx) xb_add(&bar[XB_TOPGEN], 1u);
            else XB_SPIN(xb_ld(&bar[XB_TOPGEN]) == tg, bar);
            __builtin_amdgcn_fence(__ATOMIC_ACQUIRE, "agent");
            xb_add(&bar[XB_XGEN(b.x)], 1u);
            asm volatile("s_waitcnt vmcnt(0)" ::: "memory");
        } else {
            XB_SPIN(xb_ld(&bar[XB_XGEN(b.x)]) == gen, bar);
            __builtin_amdgcn_fence(__ATOMIC_ACQUIRE, "agent");
            asm volatile("s_waitcnt vmcnt(0)" ::: "memory");
        }
    }
    __syncthreads();
}


__device__ __forceinline__ void subset_barrier(unsigned* ctr, unsigned target) {
    asm volatile("s_waitcnt vmcnt(0)" ::: "memory");
    __syncthreads();
    if (threadIdx.x == 0) {
        __builtin_amdgcn_fence(__ATOMIC_RELEASE, "agent");
        asm volatile("s_waitcnt vmcnt(0)" ::: "memory");
        (void)xb_add(ctr, 1u);
        unsigned sp = 0u;
        while (xb_ld(ctr) < target) { __builtin_amdgcn_s_sleep(2); if (++sp > (1u << 22)) break; }
        __builtin_amdgcn_fence(__ATOMIC_ACQUIRE, "agent");
        asm volatile("s_waitcnt vmcnt(0)" ::: "memory");
    }
    __syncthreads();
}

__device__ __forceinline__ int rope_pos(int g, int row) { const int gr = grow(g, row); return gr < NPTOK ? (gr & 4095) : ((gr - NPTOK) & 8191); }
struct EpiAll {
    static constexpr bool PERM = true;
    int mode;
    bf16_t* O; const bf16_t* proj; const float* bias;
    const float* xp; const float* xs; float* out; int g, layer;
    const float* lbp; const float2* rope;
    __device__ __forceinline__ void mid(f32x4 (&acc)[2][2][4][2], const pg8::Unit& u, int wr, int wc, int fr_in, int fq_in) const {
        int fr = fr_in, fq = fq_in; asm volatile("" : "+v"(fr), "+v"(fq));
        const int row0 = u.pm * 256 + wr * 64 + fr, col0 = u.pn * 256 + wc * 32 + 8 * fq;
#pragma unroll
        for (int i = 0; i < 16; ++i) { const int ai = i >> 3, m = (i >> 1) & 3, bj = i & 1; const int n = col0 + bj * 128;
            const u32x4 gq = *(const u32x4*)(proj + (size_t)(row0 + ai * 128 + m * 16) * NC1 + C_MG + (n >> 7) * 256 + (n & 127));
            acc[ai][bj][m][0][0] *= bf_lo(gq.x); acc[ai][bj][m][0][1] *= bf_hi(gq.x); acc[ai][bj][m][0][2] *= bf_lo(gq.y); acc[ai][bj][m][0][3] *= bf_hi(gq.y);
            acc[ai][bj][m][1][0] *= bf_lo(gq.z); acc[ai][bj][m][1][1] *= bf_hi(gq.z); acc[ai][bj][m][1][2] *= bf_lo(gq.w); acc[ai][bj][m][1][3] *= bf_hi(gq.w); }
    }
    __device__ __forceinline__ void operator()(const f32x4 (&acc)[2][2][4][2], const pg8::Unit& u, int wr, int wc, int fr_in, int fq_in) const {
        int fr = fr_in, fq = fq_in; asm volatile("" : "+v"(fr), "+v"(fq));
        const int row0 = u.pm * 256 + wr * 64 + fr, col0 = u.pn * 256 + wc * 32 + 8 * fq;
        if (mode == 0) {
            const int pn = u.pn;
            const int kind = (pn < 4) ? 1 : (pn < 12) ? 2 : (pn < 20) ? 0 : (pn < 24) ? 4 : (pn < 32) ? 0 : 5;
            f32x4 den[2][4][2];
#pragma unroll
            for (int bj = 0; bj < 2; ++bj) {
                const int col = col0 + bj * 128;
                f32x4 b0 = (f32x4){0.f, 0.f, 0.f, 0.f}, b1 = b0, c0 = (f32x4){1.f, 1.f, 1.f, 1.f}, c1 = c0;
                if (kind == 5) { const int nb = (pn - 32) * 128 + wc * 32 + 8 * fq + bj * 1024; b0 = *(const f32x4*)(bias + nb); b1 = *(const f32x4*)(bias + nb + 4); }
                if (kind == 2) {
                    if (layer == 1) { const int ch = col & 1023;
                        const f32x4 a0 = *(const f32x4*)(lbp + ch), a1 = *(const f32x4*)(lbp + ch + 4), d0 = *(const f32x4*)(lbp + 1024 + ch), d1 = *(const f32x4*)(lbp + 1024 + ch + 4);
#pragma unroll
                        for (int j = 0; j < 4; ++j) { const float l0 = sigmoidf_(d0[j] - a0[j]), l1 = sigmoidf_(d1[j] - a1[j]);
                            b0[j] = fmaxf(l0, 1e-30f); b1[j] = fmaxf(l1, 1e-30f); c0[j] = 1.0f - l0; c1[j] = 1.0f - l1; } }
                    else { b0 = (f32x4){1e-30f, 1e-30f, 1e-30f, 1e-30f}; b1 = b0; } }
                f32x4 rr0[4], rr1[4];
#define ROPE_PTR(idx) ((const f32x4*)(rope + (size_t)rope_pos(g, row0 + (((idx) >> 2) & 1) * 128 + ((idx) & 3) * 16) * 32 + ((col & 63) >> 1)))
                if (kind == 4) {
#pragma unroll
                    for (int k = 0; k < 4; ++k) { const f32x4* rp = ROPE_PTR(k); rr0[k] = rp[0]; rr1[k] = rp[1]; } }
#pragma unroll
                for (int ai = 0; ai < 2; ++ai)
#pragma unroll
                    for (int m = 0; m < 4; ++m) { f32x4 v0 = acc[ai][bj][m][0], v1 = acc[ai][bj][m][1];
                        const int row = row0 + ai * 128 + m * 16;
                        if (kind == 1) {
#pragma unroll
                            for (int j = 0; j < 4; ++j) { v0[j] = v0[j] * sigmoidf_(v0[j]) * 0.08838834764831845f; v1[j] = v1[j] * sigmoidf_(v1[j]) * 0.08838834764831845f; }
                        } else if (kind == 2) {
#pragma unroll
                            for (int j = 0; j < 4; ++j) { const float x0 = fminf(fmaxf(v0[j], -30.f), 30.f), x1 = fminf(fmaxf(v1[j], -30.f), 30.f);
                                v0[j] = __builtin_amdgcn_logf(b0[j] + c0[j] * sigmoidf_(x0)); v1[j] = __builtin_amdgcn_logf(b1[j] + c1[j] * sigmoidf_(x1)); }
                        } else if (kind == 3) {
#pragma unroll
                            for (int j = 0; j < 4; ++j) { v0[j] = v0[j] * sigmoidf_(v0[j]); v1[j] = v1[j] * sigmoidf_(v1[j]); }
                        } else if (kind == 4) {
                            const int idx = ai * 4 + m;
                            const f32x4 r0 = rr0[idx & 3], r1 = rr1[idx & 3]; const float qs = (pn < 22) ? 0.125f : 1.0f;
                            if (idx + 4 < 8) { const f32x4* rp = ROPE_PTR(idx + 4); rr0[idx & 3] = rp[0]; rr1[idx & 3] = rp[1]; }
                            f32x4 w0, w1;
                            w0[0] = (v0[0] * r0[0] - v0[1] * r0[1]) * qs; w0[1] = (v0[0] * r0[1] + v0[1] * r0[0]) * qs; w0[2] = (v0[2] * r0[2] - v0[3] * r0[3]) * qs; w0[3] = (v0[2] * r0[3] + v0[3] * r0[2]) * qs;
                            w1[0] = (v1[0] * r1[0] - v1[1] * r1[1]) * qs; w1[1] = (v1[0] * r1[1] + v1[1] * r1[0]) * qs; w1[2] = (v1[2] * r1[2] - v1[3] * r1[3]) * qs; w1[3] = (v1[2] * r1[3] + v1[3] * r1[2]) * qs;
                            v0 = w0; v1 = w1;
                        } else if (kind == 5) {
                            v0 += b0; v1 += b1;
#pragma unroll
                            for (int j = 0; j < 4; ++j) { v0[j] = 1.0f + exp2_(-1.4426950408889634f * v0[j]); v1[j] = 1.0f + exp2_(-1.4426950408889634f * v1[j]); }
                            if (bj == 0) { den[ai][m][0] = v0; den[ai][m][1] = v1; continue; }
                            f32x4 s0, s1, q0, q1;
#pragma unroll
                            for (int j = 0; j < 4; ++j) { s0[j] = rcp_(v0[j]); s1[j] = rcp_(v1[j]); q0[j] = v0[j] * rcp_(den[ai][m][0][j]); q1[j] = v1[j] * rcp_(den[ai][m][1][j]); }
                            u32x4 wq; wq.x = cvt_pk_bf16(q0[0], q0[1]); wq.y = cvt_pk_bf16(q0[2], q0[3]); wq.z = cvt_pk_bf16(q1[0], q1[1]); wq.w = cvt_pk_bf16(q1[2], q1[3]);
                            *(u32x4*)(O + (size_t)row * NC1 + col - 128) = wq;
                            v0 = s0; v1 = s1; }
                        u32x4 w; w.x = cvt_pk_bf16(v0[0], v0[1]); w.y = cvt_pk_bf16(v0[2], v0[3]); w.z = cvt_pk_bf16(v1[0], v1[1]); w.w = cvt_pk_bf16(v1[2], v1[3]);
                        *(u32x4*)(O + (size_t)row * NC1 + col) = w;
                        } }
        } else if (mode == 3) {
            const int gr0 = grow(g, u.pm * 256), s = seq_of(gr0);
            const float* xb = layer ? (const float*)out + (size_t)gr0 * 1024 : (gr0 < NPTOK ? xp + (size_t)gr0 * 1024 : xs + (size_t)(gr0 - NPTOK) * 1024);
            float* ob = out + (size_t)gr0 * 1024;
            const int rl0 = wr * 64 + fr;
            f32x4 gv[2][2];
#pragma unroll
            for (int bj = 0; bj < 2; ++bj) { gv[bj][0] = *(const f32x4*)(bias + s * 3072 + 2048 + col0 + bj * 128) + 1.0f; gv[bj][1] = *(const f32x4*)(bias + s * 3072 + 2048 + col0 + bj * 128 + 4) + 1.0f; }
            f32x4 xr[4][2];
#define E3_OFF(i) ((size_t)(rl0 + ((i) >> 3) * 128 + (((i) >> 1) & 3) * 16) * 1024 + col0 + ((i) & 1) * 128)
#pragma unroll
            for (int k = 0; k < 4; ++k) { xr[k][0] = *(const f32x4*)(xb + E3_OFF(k)); xr[k][1] = *(const f32x4*)(xb + E3_OFF(k) + 4); }
#pragma unroll
            for (int i = 0; i < 16; ++i) {
                const f32x4 x0 = xr[i & 3][0], x1 = xr[i & 3][1];
                if (i + 4 < 16) { xr[i & 3][0] = *(const f32x4*)(xb + E3_OFF(i + 4)); xr[i & 3][1] = *(const f32x4*)(xb + E3_OFF(i + 4) + 4); }
                const int ai = i >> 3, m = (i >> 1) & 3, bj = i & 1;
                *(f32x4*)(ob + E3_OFF(i)) = x0 * DN_ALPHA + gv[bj][0] * acc[ai][bj][m][0]; *(f32x4*)(ob + E3_OFF(i) + 4) = x1 * DN_ALPHA + gv[bj][1] * acc[ai][bj][m][1];
            }
#undef E3_OFF
        } else {
            u32x4 gr[6];
#define E2_ROW(i) ((size_t)(row0 + ((i) >> 3) * 128 + (((i) >> 1) & 3) * 16))
#define E2_COL(i) (col0 + ((i) & 1) * 128)
#define E2_G(i) (C_MG + (E2_COL(i) >> 7) * 256 + 128 + (E2_COL(i) & 127))
#pragma unroll
            for (int k = 0; k < 6; ++k) gr[k] = *(const u32x4*)(proj + E2_ROW(k) * NC1 + E2_G(k));
#pragma unroll
            for (int i = 0; i < 16; ++i) {
                const u32x4 ga = gr[i % 6];
                if (i + 6 < 16) gr[i % 6] = *(const u32x4*)(proj + E2_ROW(i + 6) * NC1 + E2_G(i + 6));
                const int ai = i >> 3, m = (i >> 1) & 3, bj = i & 1;
                f32x4 v0 = acc[ai][bj][m][0], v1 = acc[ai][bj][m][1];
                v0[0] *= bf_lo(ga.x); v0[1] *= bf_hi(ga.x); v0[2] *= bf_lo(ga.y); v0[3] *= bf_hi(ga.y);
                v1[0] *= bf_lo(ga.z); v1[1] *= bf_hi(ga.z); v1[2] *= bf_lo(ga.w); v1[3] *= bf_hi(ga.w);
                u32x4 w; w.x = cvt_pk_bf16(v0[0], v0[1]); w.y = cvt_pk_bf16(v0[2], v0[3]); w.z = cvt_pk_bf16(v1[0], v1[1]); w.w = cvt_pk_bf16(v1[2], v1[3]);
                *(u32x4*)(O + E2_ROW(i) * 1024 + E2_COL(i)) = w;
            }
#undef E2_ROW
#undef E2_COL
#undef E2_G
        }
    }
};

__device__ __forceinline__ void phase_init(const Params& p, LAS unsigned char* lds) {
    int tid_ = threadIdx.x; asm volatile("" : "+v"(tid_));
    const int tid = tid_, nb = gridDim.x, b = blockIdx.x;
    LAS float* tile = (LAS float*)lds;
    for (int u = b; u < 2 * 208 * 16; u += nb) {
        const int l = u / (208 * 16), rem = u % (208 * 16), ntile = rem >> 4, kt = rem & 15;
        const float* src; int ldsrc, ncol0; bf16_t* dst;
        if (ntile < 128)      { src = p.w_in + (size_t)l * 1024 * 8192; ldsrc = 8192; ncol0 = ntile * 64;         dst = (bf16_t*)(p.ws + WS_WT1) + ((size_t)l * 10240 + ncol0) * 1024; }
        else if (ntile < 160) { src = p.w_mg + (size_t)l * 1024 * 2048; ldsrc = 2048; ncol0 = (ntile - 128) * 64; dst = (bf16_t*)(p.ws + WS_WT1) + ((size_t)l * 10240 + 8192 + ncol0) * 1024; }
        else if (ntile < 176) { src = p.w_pa + (size_t)l * 1024 * 1024; ldsrc = 1024; ncol0 = (ntile - 160) * 64; dst = (bf16_t*)(p.ws + WS_WPA) + ((size_t)l * 1024 + ncol0) * 1024; }
        else if (ntile < 192) { src = p.w_pb + (size_t)l * 1024 * 1024; ldsrc = 1024; ncol0 = (ntile - 176) * 64; dst = (bf16_t*)(p.ws + WS_WPB) + ((size_t)l * 1024 + ncol0) * 1024; }
        else                  { src = p.w_out + (size_t)l * 1024 * 1024; ldsrc = 1024; ncol0 = (ntile - 192) * 64; dst = (bf16_t*)(p.ws + WS_WOUT) + ((size_t)l * 1024 + ncol0) * 1024; }
        const int k0 = kt * 64;
        { const int kr = tid >> 3, c8 = (tid & 7) * 8; const float* s = src + (size_t)(k0 + kr) * ldsrc + ncol0 + c8;
          const f32x4 a = *(const f32x4*)s, c = *(const f32x4*)(s + 4);
#pragma unroll
          for (int j = 0; j < 4; ++j) { tile[kr * 65 + c8 + j] = a[j]; tile[kr * 65 + c8 + 4 + j] = c[j]; } }
        __syncthreads();
        { const int n = tid >> 3, kg = (tid & 7) * 8; float v[8];
#pragma unroll
          for (int j = 0; j < 8; ++j) v[j] = tile[(kg + j) * 65 + n];
          u32x4 w; w.x = cvt_pk_bf16(v[0], v[1]); w.y = cvt_pk_bf16(v[2], v[3]); w.z = cvt_pk_bf16(v[4], v[5]); w.w = cvt_pk_bf16(v[6], v[7]);
          int np = n;
          if (ntile >= 80 && ntile < 96) np = ((n & 31) << 1) | (n >> 5);
          if (ntile >= 128 && ntile < 160) { const int L = (ntile - 128) * 64 + n, which = L >> 10, nn = L & 1023; np = (nn >> 7) * 256 + which * 128 + (nn & 127) - (ntile - 128) * 64; }
          *(u32x4*)(dst + (ptrdiff_t)np * 1024 + k0 + kg) = w; }
        __syncthreads();
    }
    float* adap = (float*)(p.ws + WS_PROJ);
    for (int u = b; u < 96; u += nb) {
        const int cb = u % 6, ks = (u / 6) % 8, l = u / 48;
        __syncthreads();
        for (int e = tid; e < 18 * 128; e += 512) { const int s = e >> 7, k = e & 127;
            const float c = (s < 16) ? p.c_prompt[s * 1024 + ks * 128 + k] : p.c_sample[(s - 16) * 1024 + ks * 128 + k];
            tile[e] = c / (1.0f + __expf(-c)); }
        __syncthreads();
        const int n = cb * 512 + tid; float acc[18];
#pragma unroll
        for (int s = 0; s < 18; ++s) acc[s] = 0.f;
        const float* w = p.w_ada + (size_t)l * 1024 * 3072 + (size_t)(ks * 128) * 3072 + n;
#pragma unroll 4
        for (int k = 0; k < 128; ++k) { const float wv = w[(size_t)k * 3072];
#pragma unroll
            for (int s = 0; s < 18; ++s) acc[s] += tile[s * 128 + k] * wv; }
#pragma unroll
        for (int s = 0; s < 18; ++s) adap[(size_t)((ks * 2 + l) * 18 + s) * 3072 + n] = acc[s];
    }
    float2* rope = (float2*)(p.ws + WS_ROPE);
    for (int e = b * 512 + tid; e < 8192 * 32; e += nb * 512) {
        const int pos = e >> 5, i = e & 31;
        double inv = 1.0; for (int k = 0; k < i; ++k) inv *= 0.7498942093324559;
        const double rev = (double)pos * inv * 0.15915494309189533577;
        double fr = rev - floor(rev); if (fr > 0.5) fr -= 1.0;
        const double r = fr * 6.28318530717958647692, r2 = r * r;
        double s = 1.0, c = 1.0;
#pragma unroll
        for (int n = 13; n >= 1; --n) { s = 1.0 - s * r2 * (1.0 / (double)((2 * n) * (2 * n + 1))); c = 1.0 - c * r2 * (1.0 / (double)((2 * n - 1) * (2 * n))); }
        rope[e] = make_float2((float)c, (float)(s * r));
    }
}

__device__ __forceinline__ void phase_ada_fin(const Params& p) {
    const float* adap = (const float*)(p.ws + WS_PROJ); float* ada = (float*)(p.ws + WS_ADA);
    int tid_ = threadIdx.x; asm volatile("" : "+v"(tid_));
    for (int e = blockIdx.x * 512 + tid_; e < 2 * 18 * 3072; e += gridDim.x * 512) {
        const int l = e / (18 * 3072), n = e % 3072; float a = p.b_ada[l * 3072 + n];
#pragma unroll
        for (int ks = 0; ks < 8; ++ks) a += adap[(size_t)ks * 110592 + e];
        ada[e] = a;
    }
}

__device__ __forceinline__ void phase_prep(const Params& p, int l, int g) {
    int tid_ = threadIdx.x; asm volatile("" : "+v"(tid_));
    const int tid = tid_; const float* ada = (const float*)(p.ws + WS_ADA) + l * 18 * 3072;
    unsigned* U32 = (unsigned*)(p.ws + WS_U);
    for (int strip = blockIdx.x; strip < MG / 16; strip += gridDim.x) {
        const int r0 = strip * 16, gr0 = grow(g, r0), s = seq_of(gr0);
        const float* src = l ? (const float*)p.out + (size_t)gr0 * 1024 : (gr0 < NPTOK ? p.x_prompt + (size_t)gr0 * 1024 : p.x_sample + (size_t)(gr0 - NPTOK) * 1024);
        const float2 sh = *(const float2*)(ada + s * 3072 + 2 * tid), sc = *(const float2*)(ada + s * 3072 + 1024 + 2 * tid);
#pragma unroll 8
        for (int i = 0; i < 16; ++i) { const float2 x = *(const float2*)(src + (size_t)i * 1024 + 2 * tid);
            U32[(size_t)(r0 + i) * 512 + tid] = cvt_pk_bf16(x.x * (1.0f + sc.x) + sh.x, x.y * (1.0f + sc.y) + sh.y); }
    }
}

__device__ __forceinline__ void ln_row(float* row, const f32x4 (&vin)[4], const float* gam, const float* bet, int lane, const float* ada_next, unsigned* urow) {
    f32x4 v[4]; float s = 0.f;
#pragma unroll
    for (int i = 0; i < 4; ++i) { v[i] = vin[i]; s += (v[i][0] + v[i][1]) + (v[i][2] + v[i][3]); }
#pragma unroll
    for (int o = 32; o >= 1; o >>= 1) s += __shfl_xor(s, o);
    const float mu = s * (1.0f / 1024.0f); float q = 0.f;
#pragma unroll
    for (int i = 0; i < 4; ++i) { v[i] -= mu; q += (v[i][0] * v[i][0] + v[i][1] * v[i][1]) + (v[i][2] * v[i][2] + v[i][3] * v[i][3]); }
#pragma unroll
    for (int o = 32; o >= 1; o >>= 1) q += __shfl_xor(q, o);
    const float rstd = 1.0f / sqrtf(q * (1.0f / 1024.0f) + LN_EPS);
#pragma unroll
    for (int i = 0; i < 4; ++i) { const f32x4 gm = *(const f32x4*)(gam + i * 256 + lane * 4), bt = *(const f32x4*)(bet + i * 256 + lane * 4);
        const f32x4 y = v[i] * rstd * gm + bt; *(f32x4*)(row + i * 256 + lane * 4) = y;
        if (ada_next) { const f32x4 sh = *(const f32x4*)(ada_next + i * 256 + lane * 4), sc = *(const f32x4*)(ada_next + 1024 + i * 256 + lane * 4); const f32x4 uu = y * (sc + 1.0f) + sh;
            u32x2 pk; pk.x = cvt_pk_bf16(uu[0], uu[1]); pk.y = cvt_pk_bf16(uu[2], uu[3]); *(u32x2*)(urow + i * 128 + lane * 2) = pk; } }
}
__device__ __forceinline__ void phase_ln(const Params& p, int l, int g, bool emit_u) {
    int tid_ = threadIdx.x; asm volatile("" : "+v"(tid_));
    const int lane = tid_ & 63, wv = tid_ >> 6;
    const float* gam = p.ln_g + l * 1024; const float* bet = p.ln_b + l * 1024;
    const int stride = gridDim.x * 8;
    for (int r = blockIdx.x * 8 + wv; r < MG; r += 4 * stride) {
        float* rows[4]; f32x4 v[4][4];
#pragma unroll
        for (int k = 0; k < 4; ++k) { const int rr = r + k * stride; rows[k] = p.out + (size_t)grow(g, rr < MG ? rr : r) * 1024;
#pragma unroll
            for (int i = 0; i < 4; ++i) v[k][i] = __builtin_nontemporal_load((const f32x4*)(rows[k] + i * 256 + lane * 4)); }
#pragma unroll
        for (int k = 0; k < 4; ++k) if (r + k * stride < MG) { const int rr = r + k * stride; const int sq = seq_of(grow(g, rr));
            ln_row(rows[k], v[k], gam, bet, lane, emit_u ? (const float*)(p.ws + WS_ADA) + (l + 1) * 18 * 3072 + sq * 3072 : nullptr, (unsigned*)(p.ws + WS_U) + (size_t)rr * 512); }
    }
}

struct CombIn { u32x4 a, b, g; };
__device__ __forceinline__ void comb_ptrs(const Params& p, int u, int sub, const bf16_t*& pf, const bf16_t*& pb, bf16_t*& pg) {
    bf16_t* proj = (bf16_t*)(p.ws + WS_PROJ); const bf16_t* of_r = (const bf16_t*)(p.ws + WS_U); const bf16_t* ob_r = (const bf16_t*)(p.ws + WS_OB);
    const int r = u >> 4, mh = u & 15; const bool isA = mh < 8; const int h = mh & 7;
    pf = isA ? proj + (size_t)r * NC1 + C_AFF + h * 128 + sub * 8 : of_r + (size_t)r * 1024 + h * 128 + sub * 8;
    pb = isA ? proj + (size_t)r * NC1 + C_AFB + h * 128 + sub * 8 : ob_r + (size_t)r * 1024 + h * 128 + sub * 8;
    pg = proj + (size_t)r * NC1 + (isA ? C_AG : C_RG) + h * 128 + sub * 8;
}
__device__ __forceinline__ void comb_unit(const CombIn& in, bool isA, const f32x4& nw0, const f32x4& nw1, bf16_t* pg) {
    const u32x4 a = in.a, bq = in.b, gq = in.g;
    float o[8], gt[8];
    o[0] = bf_lo(a.x) + bf_lo(bq.x); o[1] = bf_hi(a.x) + bf_hi(bq.x); o[2] = bf_lo(a.y) + bf_lo(bq.y); o[3] = bf_hi(a.y) + bf_hi(bq.y);
    o[4] = bf_lo(a.z) + bf_lo(bq.z); o[5] = bf_hi(a.z) + bf_hi(bq.z); o[6] = bf_lo(a.w) + bf_lo(bq.w); o[7] = bf_hi(a.w) + bf_hi(bq.w);
    gt[0] = bf_lo(gq.x); gt[1] = bf_hi(gq.x); gt[2] = bf_lo(gq.y); gt[3] = bf_hi(gq.y); gt[4] = bf_lo(gq.z); gt[5] = bf_hi(gq.z); gt[6] = bf_lo(gq.w); gt[7] = bf_hi(gq.w);
    if (!isA) { float s = 0.f;
#pragma unroll
        for (int j = 0; j < 8; ++j) s += o[j];
        s += __shfl_xor(s, 1); s += __shfl_xor(s, 2); s += __shfl_xor(s, 4); s += __shfl_xor(s, 8);
        const float mu = s * (1.0f / 128.0f);
#pragma unroll
        for (int j = 0; j < 8; ++j) o[j] -= mu; }
    float q = 0.f;
#pragma unroll
    for (int j = 0; j < 8; ++j) q += o[j] * o[j];
    q += __shfl_xor(q, 1); q += __shfl_xor(q, 2); q += __shfl_xor(q, 4); q += __shfl_xor(q, 8);
    const float rs = 1.0f / sqrtf(q * (1.0f / 128.0f) + LN_EPS);
    float y[8];
#pragma unroll
    for (int j = 0; j < 8; ++j) { const float wn = isA ? (j < 4 ? nw0[j & 3] : nw1[j & 3]) : 1.0f; y[j] = o[j] * rs * wn * gt[j] * sigmoidf_(gt[j]); }
    u32x4 w; w.x = cvt_pk_bf16(y[0], y[1]); w.y = cvt_pk_bf16(y[2], y[3]); w.z = cvt_pk_bf16(y[4], y[5]); w.w = cvt_pk_bf16(y[6], y[7]);
    *(u32x4*)pg = w;
}
__device__ __forceinline__ void phase_comb(const Params& p, int l, int row_lo, int nrows, int nb, int bi) {
    int tid_ = threadIdx.x; asm volatile("" : "+v"(tid_));
    const int tid = tid_, sub = tid & 15;
    const f32x4 nw0 = *(const f32x4*)(p.a_norm_w + l * 128 + sub * 8), nw1 = *(const f32x4*)(p.a_norm_w + l * 128 + sub * 8 + 4);
    const int ngrp = nb * 32, total = (row_lo + nrows) * 16;
    for (int u = row_lo * 16 + ((bi * 512 + tid) >> 4); u < total; u += 4 * ngrp) {
        CombIn in[4]; bf16_t* pg[4];
#pragma unroll
        for (int k = 0; k < 4; ++k) { const int uu = (u + k * ngrp < total) ? u + k * ngrp : u; const bf16_t* pf; const bf16_t* pb; comb_ptrs(p, uu, sub, pf, pb, pg[k]);
            in[k].a = __builtin_nontemporal_load((const u32x4*)pf); in[k].b = __builtin_nontemporal_load((const u32x4*)pb); in[k].g = __builtin_nontemporal_load((const u32x4*)pg[k]); }
#pragma unroll
        for (int k = 0; k < 4; ++k) if (u + k * ngrp < total) comb_unit(in[k], (u & 15) < 8, nw0, nw1, pg[k]);
    }
}

__device__ __forceinline__ bf16x8 ldfrag(const LAS unsigned char* base, int pitch, int tile, int ks, int fr, int fq) {
    return *(const LAS bf16x8*)(base + (tile * 16 + fr) * pitch + (ks * 32 + fq * 8) * 2);
}
#define LDS_BARRIER() do { asm volatile("s_waitcnt lgkmcnt(0)" ::: "memory"); __builtin_amdgcn_s_barrier(); asm volatile("" ::: "memory"); } while (0)
#define MFMA16(a, b, c) __builtin_amdgcn_mfma_f32_16x16x32_bf16((a), (b), (c), 0, 0, 0)

constexpr int MIX_LDS_MAX = 139264;
template <int DK, bool IS_A, int NDV>
__device__ __forceinline__ void mix_stream(const Params& p, LAS unsigned char* lds, int l, int rs, int T, int h, int dir, int dvh) {
    constexpr int QP = (DK + 8) * 2, TP = 144, KS = DK / 32;
    static_assert(NDV == 8, "tile ownership below is written for all 128 value channels");
    constexpr int DVW = IS_A ? 4 : 2;
    constexpr int NTV = 2 * DVW, NO = NDV / 2;
    constexpr int OFF_Q = 0, OFF_K = OFF_Q + 64 * QP, OFF_VT = OFF_K + 64 * QP, OFF_KT = OFF_VT + 128 * TP, OFF_ST = OFF_KT + DK * TP, OFF_P = OFF_ST + 128 * QP,
                  OFF_SEG = OFF_P + 64 * TP, OFF_CDEC = OFF_SEG + 8 * DK * 4, OFF_CSC = OFF_CDEC + DK * 4, OFF_O = OFF_CSC + DK * 4, OP = 272;
    static_assert(OFF_O + 64 * OP <= MIX_LDS_MAX, "mixer LDS");
    int tid_ = threadIdx.x; asm volatile("" : "+v"(tid_));
    const int tid = tid_, lane = tid & 63, w = __builtin_amdgcn_readfirstlane(tid >> 6), fr = lane & 15, fq = lane >> 4, cp = lane, sg = w;
    const int gx = ((fr + 4) >> 3) & 1, fqx = fq ^ gx, gk = ((((2 * cp) & 15) + 4) >> 3) & 1, sgx = (sg & 1) << 4;
    LAS unsigned char* Qs = lds + OFF_Q; LAS unsigned char* Ks = lds + OFF_K; LAS unsigned char* Vt = lds + OFF_VT; LAS unsigned char* Kt = lds + OFF_KT;
    LAS unsigned char* St = lds + OFF_ST; LAS unsigned char* Ps = lds + OFF_P; LAS unsigned char* Os = lds + OFF_O;
    LAS float* seg = (LAS float*)(lds + OFF_SEG); LAS float* cdec = (LAS float*)(lds + OFF_CDEC); LAS float* csc = (LAS float*)(lds + OFF_CSC);
    const bf16_t* proj = (const bf16_t*)(p.ws + WS_PROJ);
    const int N = T >> 6;
    const int cq = IS_A ? (C_AQ + h * 128) : (C_RQ + h * 64);
    const int cf = IS_A ? ((dir ? C_AFB : C_AFF) + h * 128) : (C_RK + h * 64);
    const int cv = (IS_A ? (C_AI + h * 128) : (C_RV + h * 128)) + dvh * 64;
    bf16_t* obase; int opitch, ocol;
    if (IS_A) { obase = (bf16_t*)(p.ws + WS_PROJ); opitch = NC1; ocol = (dir ? C_AFB : C_AFF) + h * 128 + dvh * 64; }
    else { obase = (bf16_t*)(p.ws + (dir ? WS_OB : WS_U)); opitch = 1024; ocol = h * 128 + dvh * 64; }
    float lg = 0.f;
    if (!IS_A) { const float x = p.ret_decay[l * 16 + dir * 8 + h]; lg = -log1pf(expf(-x)); }
    const int tdk0 = IS_A ? 2 * (w & 3) : 2 * (w & 1), tdv0 = IS_A ? (w >> 2) * 4 : (w >> 1) * 2;

    f32x4 S[NTV], U[NTV];
#pragma unroll
    for (int i = 0; i < NTV; ++i) { S[i] = (f32x4){0.f, 0.f, 0.f, 0.f}; U[i] = (f32x4){0.f, 0.f, 0.f, 0.f}; }
    unsigned rq[2][8], rv[2][8], rf[2][8];
    unsigned vo[8];
#pragma unroll
    for (int i = 0; i < 8; ++i) { const int t = sg * 8 + i; vo[i] = (unsigned)((dir ? 63 - t : t) * (NC1 * 2)); }
    const unsigned cqk_b = IS_A ? (unsigned)(cq * 2 + 4 * cp) : (unsigned)((cp < 32 ? cq : cf) * 2 + 4 * (cp & 31));
    const unsigned cf_b = (unsigned)(cf * 2 + 4 * cp), cv_b = (unsigned)(cv * 2 + 4 * cp);
#define MIX_RB(nn) (rs + (dir ? T - 64 - (nn) * 64 : (nn) * 64))
#define MIX_LOAD(nn, pp) do { const char* cb = (const char*)proj + (size_t)MIX_RB(nn) * (NC1 * 2); \
        _Pragma("unroll") for (int i = 0; i < 8; ++i) { \
        rq[pp][i] = *(const unsigned*)(cb + (vo[i] + cqk_b)); \
        if (IS_A) rf[pp][i] = *(const unsigned*)(cb + (vo[i] + cf_b)); \
        if (NDV == 8 || cp < 32) rv[pp][i] = *(const unsigned*)(cb + (vo[i] + cv_b)); } } while (0)
    const unsigned fo = (unsigned)((dir ? 63 - (tid >> 3) : (tid >> 3)) * opitch * 2 + (ocol + (tid & 7) * (NDV == 8 ? 16 : 8)) * 2);
#define MIX_FLUSH(nn) do { char* ob_ = (char*)obase + (size_t)MIX_RB(nn) * (opitch * 2) + fo; \
        if (NDV == 8) { const LAS unsigned char* src = Os + (tid >> 3) * OP + (tid & 7) * 32; \
            const u32x4 v0 = *(const LAS u32x4*)src, v1 = *(const LAS u32x4*)(src + 16); *(u32x4*)ob_ = v0; *(u32x4*)(ob_ + 16) = v1; } \
        else { const LAS unsigned char* src = Os + (tid >> 3) * OP + (tid & 7) * 16; const u32x4 v0 = *(const LAS u32x4*)src; *(u32x4*)ob_ = v0; } } while (0)
    MIX_LOAD(0, 0);
    for (int n = 0; n < N; ++n) { constexpr int par = 0;
        if (IS_A) {
            float run0 = 0.f, run1 = 0.f;
#pragma unroll
            for (int i = 0; i < 8; ++i) { run0 += bf_lo(rf[par][i]); run1 += bf_hi(rf[par][i]); }
            *(LAS f32x2*)(seg + sg * DK + 2 * cp) = (f32x2){run0, run1};
        }
        LDS_BARRIER();
        if (n > 0) MIX_FLUSH(n - 1);
        {
            unsigned kt0[4], kt1[4], vt0[4], vt1[4];
            if (IS_A) {
                float pre0 = 0.f, pre1 = 0.f, ref0 = 0.f, ref1 = 0.f, tot0 = 0.f, tot1 = 0.f;
#pragma unroll
                for (int s8 = 0; s8 < 8; ++s8) { const f32x2 v = *(const LAS f32x2*)(seg + s8 * DK + 2 * cp);
                    if (s8 < sg) { pre0 += v.x; pre1 += v.y; } if (s8 < 4) { ref0 += v.x; ref1 += v.y; } tot0 += v.x; tot1 += v.y; }
                f32x2 E = (f32x2){exp2_(fminf(fmaxf(pre0 - ref0, -115.f), 115.f)), exp2_(fminf(fmaxf(pre1 - ref1, -115.f), 115.f))};
#pragma unroll
                for (int ip = 0; ip < 4; ++ip) { unsigned kp[2];
#pragma unroll
                    for (int e = 0; e < 2; ++e) { const int i = 2 * ip + e;
                        const f32x2 f = (f32x2){exp2_(bf_lo(rf[par][i])), exp2_(bf_hi(rf[par][i]))};
                        E = __builtin_elementwise_max(E * f, (f32x2){1e-35f, 1e-35f});
                        const f32x2 r = (f32x2){rcp_(E.x), rcp_(E.y)};
                        const f32x2 k = r - f * r;
                        const f32x2 qv = (f32x2){bf_lo(rq[par][i]), bf_hi(rq[par][i])} * E;
                        const int t = sg * 8 + i;
                        const int cb4 = (4 * cp) ^ ((i >= 4 ? 16 : 0) ^ sgx);
                        *(LAS unsigned*)(Qs + t * QP + cb4) = cvt_pk_bf16(qv.x, qv.y);
                        kp[e] = cvt_pk_bf16(k.x, k.y);
                        *(LAS unsigned*)(Ks + t * QP + cb4) = kp[e]; }
                    kt0[ip] = __builtin_amdgcn_perm(kp[1], kp[0], 0x05040100u); kt1[ip] = __builtin_amdgcn_perm(kp[1], kp[0], 0x07060302u);
                    vt0[ip] = __builtin_amdgcn_perm(rv[par][2 * ip + 1], rv[par][2 * ip], 0x05040100u); vt1[ip] = __builtin_amdgcn_perm(rv[par][2 * ip + 1], rv[par][2 * ip], 0x07060302u);
                }
                if (sg == 0) { *(LAS f32x2*)(cdec + 2 * cp) = (f32x2){exp2_(fmaxf(tot0, -115.f)), exp2_(fmaxf(tot1, -115.f))};
                               *(LAS f32x2*)(csc + 2 * cp) = (f32x2){exp2_(fmaxf(tot0 - ref0, -115.f)), exp2_(fmaxf(tot1 - ref1, -115.f))}; }
                *(LAS u32x4*)(Kt + (2 * cp) * TP + ((sg * 16) ^ (gk << 4))) = (u32x4){kt0[0], kt0[1], kt0[2], kt0[3]};
                *(LAS u32x4*)(Kt + (2 * cp + 1) * TP + ((sg * 16) ^ (gk << 4))) = (u32x4){kt1[0], kt1[1], kt1[2], kt1[3]};
            } else {
                const int ci = cp & 31;
#pragma unroll
                for (int ip = 0; ip < 4; ++ip) { unsigned kp[2];
#pragma unroll
                    for (int e = 0; e < 2; ++e) { const int i = 2 * ip + e; const int t = sg * 8 + i;
                        const float dd = (float)(t - 31) * lg;
                        const float sc = __expf(cp < 32 ? dd : -dd);
                        kp[e] = cvt_pk_bf16(bf_lo(rq[par][i]) * sc, bf_hi(rq[par][i]) * sc);
                        *(LAS unsigned*)((cp < 32 ? Qs : Ks) + t * QP + ((4 * ci) ^ ((i >= 4 ? 16 : 0) ^ sgx))) = kp[e]; }
                    kt0[ip] = __builtin_amdgcn_perm(kp[1], kp[0], 0x05040100u); kt1[ip] = __builtin_amdgcn_perm(kp[1], kp[0], 0x07060302u);
                    vt0[ip] = __builtin_amdgcn_perm(rv[par][2 * ip + 1], rv[par][2 * ip], 0x05040100u); vt1[ip] = __builtin_amdgcn_perm(rv[par][2 * ip + 1], rv[par][2 * ip], 0x07060302u);
                }
                if (cp >= 32) { *(LAS u32x4*)(Kt + (2 * ci) * TP + ((sg * 16) ^ (gk << 4))) = (u32x4){kt0[0], kt0[1], kt0[2], kt0[3]};
                                *(LAS u32x4*)(Kt + (2 * ci + 1) * TP + ((sg * 16) ^ (gk << 4))) = (u32x4){kt1[0], kt1[1], kt1[2], kt1[3]}; }
            }
            if (NDV == 8 || cp < 32) {
            *(LAS u32x4*)(Vt + (2 * cp) * TP + ((sg * 16) ^ (gk << 4))) = (u32x4){vt0[0], vt0[1], vt0[2], vt0[3]};
            *(LAS u32x4*)(Vt + (2 * cp + 1) * TP + ((sg * 16) ^ (gk << 4))) = (u32x4){vt1[0], vt1[1], vt1[2], vt1[3]}; }
        }
#pragma unroll
        for (int dki = 0; dki < 2; ++dki) { f32x4 er;
          if (IS_A) { const int dk = (tdk0 + dki) * 16 + fq * 4; const f32x4 e = *(const LAS f32x4*)(seg + dk) + *(const LAS f32x4*)(seg + DK + dk) + *(const LAS f32x4*)(seg + 2 * DK + dk) + *(const LAS f32x4*)(seg + 3 * DK + dk);
#pragma unroll
              for (int j = 0; j < 4; ++j) er[j] = exp2_(fmaxf(e[j], -115.f)); }
          else { const float e = __expf(32.0f * lg); er = (f32x4){e, e, e, e}; }
#pragma unroll
          for (int dvi = 0; dvi < DVW; ++dvi) { const f32x4 sv = S[dki * DVW + dvi] * er; u32x2 pk; pk.x = cvt_pk_bf16(sv[0], sv[1]); pk.y = cvt_pk_bf16(sv[2], sv[3]);
              *(LAS u32x2*)(St + ((tdv0 + dvi) * 16 + fr) * QP + ((((tdk0 + dki) * 16 + fq * 4) * 2) ^ (gx << 4))) = pk; } }
        if (n + 1 < N) MIX_LOAD(n + 1, par);
        LDS_BARRIER();
        { const int tt = w >> 1, ts0 = (w & 1) * 2; f32x4 pa = (f32x4){0.f, 0.f, 0.f, 0.f}, pb = pa;
          bf16x8 gq_[KS], gk0[KS], gk1[KS];
#pragma unroll
          for (int ks = 0; ks < KS; ++ks) { gq_[ks] = ldfrag(Qs, QP, tt, ks, fr, fqx); gk0[ks] = ldfrag(Ks, QP, ts0, ks, fr, fqx); gk1[ks] = ldfrag(Ks, QP, ts0 + 1, ks, fr, fqx); }
          __builtin_amdgcn_sched_barrier(0);
#pragma unroll
          for (int ks = 0; ks < KS; ++ks) { pa = MFMA16(gk0[ks], gq_[ks], pa); pb = MFMA16(gk1[ks], gq_[ks], pb); }
          const int t = tt * 16 + fr, s0 = ts0 * 16 + fq * 4, s1 = s0 + 16;
          u32x2 w0, w1;
          w0.x = cvt_pk_bf16(t >= s0 ? pa[0] : 0.f, t >= s0 + 1 ? pa[1] : 0.f); w0.y = cvt_pk_bf16(t >= s0 + 2 ? pa[2] : 0.f, t >= s0 + 3 ? pa[3] : 0.f);
          w1.x = cvt_pk_bf16(t >= s1 ? pb[0] : 0.f, t >= s1 + 1 ? pb[1] : 0.f); w1.y = cvt_pk_bf16(t >= s1 + 2 ? pb[2] : 0.f, t >= s1 + 3 ? pb[3] : 0.f);
          *(LAS u32x2*)(Ps + t * TP + ((s0 * 2) ^ (gx << 4))) = w0; *(LAS u32x2*)(Ps + t * TP + ((s1 * 2) ^ (gx << 4))) = w1; }
#pragma unroll
        for (int ks = 0; ks < 2; ++ks) { bf16x8 ak[2], bv[DVW];
#pragma unroll
            for (int dki = 0; dki < 2; ++dki) ak[dki] = ldfrag(Kt, TP, tdk0 + dki, ks, fr, fqx);
#pragma unroll
            for (int dvi = 0; dvi < DVW; ++dvi) bv[dvi] = ldfrag(Vt, TP, tdv0 + dvi, ks, fr, fqx);
            __builtin_amdgcn_sched_barrier(0);
#pragma unroll
            for (int dki = 0; dki < 2; ++dki)
#pragma unroll
                for (int dvi = 0; dvi < DVW; ++dvi) U[dki * DVW + dvi] = MFMA16(ak[dki], bv[dvi], U[dki * DVW + dvi]);
            __builtin_amdgcn_sched_barrier(0); }
        LDS_BARRIER();
        { const int tp = w >> 2, dp = w & 3; f32x4 o[4];
#pragma unroll
          for (int q = 0; q < 4; ++q) o[q] = (f32x4){0.f, 0.f, 0.f, 0.f};
#pragma unroll
          for (int kb = 0; kb < KS; kb += 2) { bf16x8 b[2][2], a[2][2];
#pragma unroll
              for (int k2 = 0; k2 < 2; ++k2)
#pragma unroll
                  for (int i2 = 0; i2 < 2; ++i2) { b[k2][i2] = ldfrag(Qs, QP, 2 * tp + i2, kb + k2, fr, fqx); a[k2][i2] = ldfrag(St, QP, 2 * dp + i2, kb + k2, fr, fqx); }
              __builtin_amdgcn_sched_barrier(0);
#pragma unroll
              for (int k2 = 0; k2 < 2; ++k2)
#pragma unroll
                  for (int ti = 0; ti < 2; ++ti)
#pragma unroll
                      for (int di = 0; di < 2; ++di) o[ti * 2 + di] = MFMA16(a[k2][di], b[k2][ti], o[ti * 2 + di]);
              __builtin_amdgcn_sched_barrier(0); }
          { bf16x8 b[2][2], a[2][2];
#pragma unroll
              for (int k2 = 0; k2 < 2; ++k2)
#pragma unroll
                  for (int i2 = 0; i2 < 2; ++i2) { b[k2][i2] = ldfrag(Ps, TP, 2 * tp + i2, k2, fr, fqx); a[k2][i2] = ldfrag(Vt, TP, 2 * dp + i2, k2, fr, fqx); }
              __builtin_amdgcn_sched_barrier(0);
#pragma unroll
              for (int k2 = 0; k2 < 2; ++k2)
#pragma unroll
                  for (int ti = 0; ti < 2; ++ti)
#pragma unroll
                      for (int di = 0; di < 2; ++di) o[ti * 2 + di] = MFMA16(a[k2][di], b[k2][ti], o[ti * 2 + di]);
              __builtin_amdgcn_sched_barrier(0); }
#pragma unroll
          for (int ti = 0; ti < 2; ++ti)
#pragma unroll
              for (int di = 0; di < 2; ++di) { const f32x4 ov = o[ti * 2 + di]; u32x2 pk; pk.x = cvt_pk_bf16(ov[0], ov[1]); pk.y = cvt_pk_bf16(ov[2], ov[3]);
                  *(LAS u32x2*)(Os + ((2 * tp + ti) * 16 + fr) * OP + ((2 * dp + di) * 16 + fq * 4) * 2) = pk; } }
#pragma unroll
        for (int dki = 0; dki < 2; ++dki) { f32x4 cd, cs;
          if (IS_A) { cd = *(const LAS f32x4*)(cdec + (tdk0 + dki) * 16 + fq * 4); cs = *(const LAS f32x4*)(csc + (tdk0 + dki) * 16 + fq * 4); }
          else { const float a = __expf(64.0f * lg), b = __expf(32.0f * lg); cd = (f32x4){a, a, a, a}; cs = (f32x4){b, b, b, b}; }
#pragma unroll
          for (int dvi = 0; dvi < DVW; ++dvi) { S[dki * DVW + dvi] = S[dki * DVW + dvi] * cd + U[dki * DVW + dvi] * cs; U[dki * DVW + dvi] = (f32x4){0.f, 0.f, 0.f, 0.f}; } }
    }
    __syncthreads();
    MIX_FLUSH(N - 1);
    __syncthreads();
#undef MIX_LOAD
#undef MIX_FLUSH
#undef MIX_RB
}

__device__ __forceinline__ void phase_mix(const Params& p, LAS unsigned char* lds, int l, int g) {
    const int G = gridDim.x, b = blockIdx.x;
    const int nstreams = g == 0 ? 256 : 320;
    for (int r = 0; r * G < nstreams; ++r) {
        const int bi = (r & 1) ? (G - 1 - b) : b; const int sidx = r * G + bi;
        if (sidx >= nstreams) continue;
        bool isA; int q, rs, T;
        if (g == 0) {
            if (sidx < 64) { isA = sidx < 32; q = sidx & 31; rs = (q >> 4) * 8192; T = 8192; }
            else { isA = sidx < 160; q = isA ? sidx - 64 : sidx - 160; rs = 16384 + (q >> 4) * 4096; T = 4096; }
        } else { isA = sidx < 160; q = isA ? sidx : sidx - 160; rs = (q >> 4) * 4096; T = 4096; }
        const int h = (q >> 1) & 7, dir = q & 1;
        if (isA) mix_stream<128, true, 8>(p, lds, l, rs, T, h, dir, 0); else mix_stream<64, false, 8>(p, lds, l, rs, T, h, dir, 0);
    }
}

constexpr int N_PHASES = 3 + 6 * 4;
constexpr int LDS_BYTES = MIX_LDS_MAX + 16;

__global__ void __launch_bounds__(512, 2) fwd_megakernel(Params p) {
    extern __shared__ __attribute__((aligned(16))) unsigned char lds_raw[];
    LAS unsigned char* lds = (LAS unsigned char*)lds_raw;
    cg::grid_group grid = cg::this_grid();
    if (threadIdx.x < 4) ((LAS unsigned*)(lds + MIX_LDS_MAX))[threadIdx.x] = 0u;
    __syncthreads();
    XcdBarrier xbar = xcd_barrier_post((unsigned*)(p.ws + WS_BAR), (volatile LAS unsigned*)(lds + MIX_LDS_MAX));
    const int G = gridDim.x, bid = blockIdx.x;
    bf16_t* proj = (bf16_t*)(p.ws + WS_PROJ); bf16_t* ubuf = (bf16_t*)(p.ws + WS_U);
    for (int ph = p.ph_lo; ph < p.ph_hi; ++ph) {
        if (ph == 0) phase_init(p, lds);
        else if (ph == 1) phase_ada_fin(p);
        else if (ph == 2) phase_prep(p, 0, 0);
        else {
            const int idx = (ph - 3) / 6, sub = (ph - 3) % 6, g = idx >> 1, l = idx & 1;
            const bool ovl = (G == 256) && (g == 0);
            bool extra = false;
            if (sub == 1) {
                phase_mix(p, lds, l, g);
                if (ovl && bid >= 64) {
                    unsigned* sb = (unsigned*)(p.ws + WS_BAR) + 3520 + l * 128;
                    subset_barrier(sb, 192u);
                    phase_comb(p, l, 16384, MG - 16384, 192, bid - 64);
                    subset_barrier(sb + 64, 192u);
                    extra = true;
                }
            }
            else if (sub == 2) { if (ovl) phase_comb(p, l, 0, 16384, G, bid); else phase_comb(p, l, 0, MG, G, bid); }
            if (sub == 0 || sub == 3 || sub == 4 || extra) {
                pg8::Gemm gm; EpiAll E; pg8::StaticOrder S;
                E.lbp = p.hgrn_lb; E.rope = (const float2*)(p.ws + WS_ROPE); E.proj = proj; E.xp = p.x_prompt; E.xs = p.x_sample; E.out = p.out; E.g = g; E.layer = l;
                if (sub == 0)      { gm = pg8::Gemm{ubuf, (const bf16_t*)(p.ws + WS_WT1) + (size_t)l * 10240 * 1024, MG, NC1, 1024, 1024, 1024, nullptr, nullptr}; E.mode = 0; E.O = proj; E.bias = p.b_mg + l * 2048; S.init(MG, NC1, G, bid); }
                else if (sub == 4) { gm = pg8::Gemm{ubuf, (const bf16_t*)(p.ws + WS_WOUT) + (size_t)l * 1024 * 1024, MG, 1024, 1024, 1024, 1024, nullptr, nullptr}; E.mode = 3; E.O = ubuf; E.bias = (const float*)(p.ws + WS_ADA) + l * 18 * 3072; S.init(MG, 1024, G, bid); }
                else { gm = pg8::Gemm{proj + C_AG, (const bf16_t*)(p.ws + WS_WPA) + (size_t)l * 1024 * 1024, MG, 1024, 1024, NC1, 1024, proj + C_RG, (const bf16_t*)(p.ws + WS_WPB) + (size_t)l * 1024 * 1024}; E.mode = 1; E.O = ubuf; E.bias = nullptr;
                    if (extra) S.init(MG - 16384, 1024, 192, bid - 64, 64); else if (ovl) S.init(16384, 1024, G, bid); else S.init(MG, 1024, G, bid); }
                pg8::gemm_phase<EpiAll>(lds, gm, S, E);
            }
            if (sub == 5) {
                phase_ln(p, l, g, l == 0);
                if (l == 1 && g == 0) phase_prep(p, 0, 1);
            }
        }
        if (ph + 1 < p.ph_hi) { if (ph == 0) grid.sync(); else xcd_barrier(xbar); }
    }
}

#ifndef ONE_LAUNCH
#define ONE_LAUNCH 1
#endif
extern "C" void kernel_launch(void* const* d_in, const int* in_sizes, int n_in, void* d_out, int out_size, void* d_ws, size_t ws_size, hipStream_t stream) {
    static int grid = 0;
    if (grid == 0) {
        if (n_in != 17 || out_size != NTOK * D || ws_size < WS_END) { fprintf(stderr, "kernel_launch: unexpected shapes / workspace (n_in %d out %d ws %zu need %zu)\n", n_in, out_size, ws_size, (size_t)WS_END); grid = -1; return; }
        int dev = 0, cus = 0, per_cu = 0;
        hipGetDevice(&dev); hipDeviceGetAttribute(&cus, hipDeviceAttributeMultiprocessorCount, dev);
        if (hipFuncSetAttribute((const void*)fwd_megakernel, hipFuncAttributeMaxDynamicSharedMemorySize, LDS_BYTES) != hipSuccess) { fprintf(stderr, "kernel_launch: hipFuncSetAttribute failed\n"); grid = -1; return; }
        if (hipOccupancyMaxActiveBlocksPerMultiprocessor(&per_cu, (const void*)fwd_megakernel, 512, LDS_BYTES) != hipSuccess || per_cu < 1) { fprintf(stderr, "kernel_launch: occupancy query says %d\n", per_cu); per_cu = 1; }
        (void)hipGetLastError();
        grid = cus;
    }
    if (grid < 0) return;
    if (hipMemsetAsync((char*)d_ws + WS_BAR, 0, 16384, stream) != hipSuccess) { fprintf(stderr, "kernel_launch: memset of the barrier words failed\n"); return; }
    Params p{};
    p.x_prompt = (const float*)d_in[0]; p.x_sample = (const float*)d_in[1]; p.c_prompt = (const float*)d_in[2]; p.c_sample = (const float*)d_in[3];
    p.w_ada = (const float*)d_in[4]; p.b_ada = (const float*)d_in[5]; p.w_in = (const float*)d_in[6]; p.hgrn_lb = (const float*)d_in[7]; p.a_norm_w = (const float*)d_in[8];
    p.ret_decay = (const float*)d_in[9]; p.w_pa = (const float*)d_in[10]; p.w_pb = (const float*)d_in[11]; p.w_mg = (const float*)d_in[12]; p.b_mg = (const float*)d_in[13];
    p.w_out = (const float*)d_in[14]; p.ln_g = (const float*)d_in[15]; p.ln_b = (const float*)d_in[16];
    p.out = (float*)d_out; p.ws = (unsigned char*)d_ws;
#if ONE_LAUNCH
    p.ph_lo = 0; p.ph_hi = N_PHASES;
    void* args[] = {&p};
    hipError_t e = hipLaunchCooperativeKernel((const void*)fwd_megakernel, dim3(grid), dim3(512), args, LDS_BYTES, stream);
    if (e != hipSuccess) fprintf(stderr, "cooperative launch failed: %s (grid %d)\n", hipGetErrorString(e), grid);
#else
    for (int ph = 0; ph < N_PHASES; ++ph) { p.ph_lo = ph; p.ph_hi = ph + 1; hipLaunchKernelGGL(fwd_megakernel, dim3(grid), dim3(512), LDS_BYTES, stream, p); }
#endif
}
```

```cpp
#include <hip/hip_runtime.h>
#include <hip/hip_cooperative_groups.h>
#include <cstdio>
#include <cmath>
namespace cg = cooperative_groups;

#define LAS __attribute__((address_space(3)))
typedef unsigned short bf16_t;
typedef short bf16x8 __attribute__((ext_vector_type(8)));
typedef float f32x4 __attribute__((ext_vector_type(4)));
typedef unsigned u32x4 __attribute__((ext_vector_type(4)));
typedef unsigned u32x2 __attribute__((ext_vector_type(2)));
typedef float f32x2 __attribute__((ext_vector_type(2)));

constexpr int D = 1024, NTOK = 81920, NPTOK = 65536, NSEQ = 18, MG = 40960, NC1 = 10240;
constexpr int C_AQ = 0, C_AFF = 1024, C_AFB = 2048, C_AI = 3072, C_AG = 4096, C_RQ = 5120, C_RK = 5632, C_RV = 6144, C_RG = 7168, C_MG = 8192;
constexpr float LN_EPS = 1e-5f;
constexpr float DN_ALPHA = 1.41421356237309515f;

constexpr size_t WS_BAR = 0;
constexpr size_t WS_WT1 = 16384;
constexpr size_t WS_WPA = WS_WT1 + (size_t)2 * 10240 * 1024 * 2;
constexpr size_t WS_WPB = WS_WPA + (size_t)2 * 1024 * 1024 * 2;
constexpr size_t WS_WOUT = WS_WPB + (size_t)2 * 1024 * 1024 * 2;
constexpr size_t WS_ADA = WS_WOUT + (size_t)2 * 1024 * 1024 * 2;
constexpr size_t WS_ROPE = WS_ADA + (size_t)2 * 18 * 3072 * 4;
constexpr size_t WS_U = WS_ROPE + (size_t)8192 * 32 * 8;
constexpr size_t WS_OB = WS_U + (size_t)MG * 1024 * 2;
constexpr size_t WS_PROJ = WS_OB + (size_t)MG * 1024 * 2;
constexpr size_t WS_END = WS_PROJ + (size_t)MG * NC1 * 2;

struct Params {
    const float* x_prompt; const float* x_sample; const float* c_prompt; const float* c_sample;
    const float* w_ada; const float* b_ada; const float* w_in; const float* hgrn_lb; const float* a_norm_w; const float* ret_decay;
    const float* w_pa; const float* w_pb; const float* w_mg; const float* b_mg; const float* w_out; const float* ln_g; const float* ln_b;
    float* out; unsigned char* ws;
    int ph_lo, ph_hi;
};

__device__ __forceinline__ int grow(int g, int r) { return g == 0 ? (r < 16384 ? 65536 + r : r - 16384) : 24576 + r; }
__device__ __forceinline__ int seq_of(int gr) { return gr < 65536 ? (gr >> 12) : 16 + ((gr - 65536) >> 13); }
__device__ __forceinline__ unsigned cvt_pk_bf16(float lo, float hi) { unsigned r; asm("v_cvt_pk_bf16_f32 %0, %1, %2" : "=v"(r) : "v"(lo), "v"(hi)); return r; }
__device__ __forceinline__ bf16_t f2bf(float f) { return (bf16_t)(cvt_pk_bf16(f, 0.f) & 0xffffu); }
__device__ __forceinline__ float bf_lo(unsigned u) { return __uint_as_float(u << 16); }
__device__ __forceinline__ float bf_hi(unsigned u) { return __uint_as_float(u & 0xffff0000u); }
__device__ __forceinline__ float bf2f(bf16_t b) { return __uint_as_float(((unsigned)b) << 16); }
__device__ __forceinline__ float rcp_(float x) { return __builtin_amdgcn_rcpf(x); }
__device__ __forceinline__ float exp2_(float x) { return __builtin_amdgcn_exp2f(x); }
__device__ __forceinline__ float sigmoidf_(float x) { return rcp_(1.0f + exp2_(-1.4426950408889634f * x)); }

namespace pg8 {
constexpr int BM = 256, BK = 64, HALF = 128, HTB = HALF * BK * 2  , STAGE_BYTES = 8 * HTB, NXCD = 8, WGM = 8;
__host__ __device__ __forceinline__ int lds_byte(int r, int c) { const int st = (r >> 4) * 2 + (c >> 5), rr = r & 15, cc = c & 31, ob = rr * 64 + cc * 2; return st * 1024 + (ob ^ (((ob >> 9) & 1) << 5)); }
__host__ __device__ __forceinline__ void stage_rc(int b, int& R, int& C) { const int st = b / 1024, sb = b % 1024, swz = sb ^ (((sb >> 9) & 1) << 5); R = (st >> 1) * 16 + swz / 64; C = (st & 1) * 32 + (swz % 64) / 2; }
__host__ __device__ __forceinline__ int perm32(int rho) { const int n = rho >> 4, i = rho & 15; return 8 * (i >> 2) + 4 * n + (i & 3); }

struct Unit { int pm, pn; };
struct Gemm { const bf16_t* A; const bf16_t* Bt; int M, N, K, lda, ldb; const bf16_t* A2; const bf16_t* Bt2; };

struct StaticOrder {
    int nM, nN, nwg, G, c, pm0;
    __host__ __device__ void init(int M, int N, int G_, int c_, int pm0_ = 0) { nM = M / BM; nN = N / BM; nwg = nM * nN; G = G_; c = c_; pm0 = pm0_; }
    __host__ __device__ bool next(int i, Unit& u) const {
        const long L = (long)i * G + c; if (L >= nwg) return false;
        int wgid = (int)L; { const int q = nwg / NXCD, r = nwg % NXCD, xcd = wgid % NXCD, off = wgid / NXCD; wgid = (xcd < r ? xcd * (q + 1) : r * (q + 1) + (xcd - r) * q) + off; }
        const int nig = WGM * nN, gid = wgid / nig, fm = gid * WGM, gsz = (nM - fm) < WGM ? (nM - fm) : WGM;
        u.pm = pm0 + fm + ((wgid % nig) % gsz); u.pn = (wgid % nig) / gsz; return true;
    }
};

template <class Epi>
__device__ __forceinline__ void gemm_phase(LAS unsigned char* lds, const Gemm g, const StaticOrder& S, const Epi& E) {
    int tid_ = threadIdx.x; asm volatile("" : "+v"(tid_));
    const int tid = tid_, wid = __builtin_amdgcn_readfirstlane(tid >> 6), lane = tid & 63, wr = wid >> 2, wc = wid & 3, fr = lane & 15, fq = lane >> 4;
    const int K = g.K, nt = K / BK, npass = g.A2 ? 2 : 1;
    unsigned voffA[2], voffB[2];
#pragma unroll
    for (int i = 0; i < 2; ++i) { int R, C; stage_rc(tid * 16 + i * 8192, R, C); const int Rb = Epi::PERM ? ((R & ~31) + perm32(R & 31)) : R;
        voffA[i] = (unsigned)(R * g.lda + C) * 2u; voffB[i] = (unsigned)(Rb * g.ldb + C) * 2u; }
    const size_t kstep = (size_t)(BK * 2);
    const size_t hstepA = (size_t)HALF * g.lda * 2, hstepB = (size_t)HALF * g.ldb * 2;
    const size_t tstepA = 2 * hstepA, tstepB = 2 * hstepB;
    const unsigned ldsw = (unsigned)wid * 1024u;
    const int aoff = lds_byte(wr * 64 + fr, fq * 8), boff = lds_byte(wc * 32 + fr, fq * 8);
#define PG8_SA(b, h) (((b) * 2 + (h)) * HTB)
#define PG8_SB(b, h) ((4 + (b) * 2 + (h)) * HTB)
#define PG8_STAGE(bufoff, gbase, voff) do { _Pragma("unroll") for (int _i = 0; _i < 2; ++_i) \
        __builtin_amdgcn_global_load_lds((const unsigned*)((const char*)(gbase) + (voff)[_i]), (LAS unsigned*)(lds + (bufoff) + ldsw + _i * 8192), 16, 0, 0); } while (0)
#define PG8_LDA(dst, b, h) do { _Pragma("unroll") for (int m = 0; m < 4; ++m) _Pragma("unroll") for (int k = 0; k < 2; ++k) dst[m][k] = *(const LAS bf16x8*)(lds + PG8_SA(b, h) + aoff + m * 2048 + k * 1024); } while (0)
#define PG8_LDB(dst, b, h) do { _Pragma("unroll") for (int n = 0; n < 2; ++n) _Pragma("unroll") for (int k = 0; k < 2; ++k) dst[n][k] = *(const LAS bf16x8*)(lds + PG8_SB(b, h) + boff + n * 2048 + k * 1024); } while (0)
#define PG8_MMA(ai, bj, At, Bt) do { __builtin_amdgcn_s_setprio(1); _Pragma("unroll") for (int m = 0; m < 4; ++m) _Pragma("unroll") for (int n = 0; n < 2; ++n) _Pragma("unroll") for (int k = 0; k < 2; ++k) \
        acc[ai][bj][m][n] = __builtin_amdgcn_mfma_f32_16x16x32_bf16(Bt[n][k], At[m][k], acc[ai][bj][m][n], 0, 0, 0); __builtin_amdgcn_s_setprio(0); } while (0)
#define PG8_WAIT_V(n) asm volatile("s_waitcnt vmcnt(" #n ")" ::: "memory")
#define PG8_WAIT_L(n) asm volatile("s_waitcnt lgkmcnt(" #n ")" ::: "memory")
#define PG8_BAR __builtin_amdgcn_s_barrier()
#define PG8_SCHED __builtin_amdgcn_sched_barrier(0)
    Unit cur, nxt; int ui = 0;
    if (!S.next(0, cur)) return;
    f32x4 acc[2][2][4][2];
#pragma unroll
    for (int a = 0; a < 2; ++a)
#pragma unroll
        for (int b = 0; b < 2; ++b)
#pragma unroll
            for (int m = 0; m < 4; ++m)
#pragma unroll
                for (int n = 0; n < 2; ++n) acc[a][b][m][n] = (f32x4){0.f, 0.f, 0.f, 0.f};
    bf16x8 At[4][2], B0[2][2], B1[2][2];
    const char* cA = (const char*)g.A + (size_t)cur.pm * tstepA; const char* cB = (const char*)g.Bt + (size_t)cur.pn * tstepB;
    PG8_STAGE(PG8_SB(0, 0), cB, voffB); PG8_STAGE(PG8_SA(0, 0), cA, voffA); PG8_STAGE(PG8_SB(0, 1), cB + hstepB, voffB); PG8_STAGE(PG8_SA(0, 1), cA + hstepA, voffA);
    if (wr == 1) PG8_BAR;
    PG8_WAIT_V(4); PG8_BAR;
    PG8_STAGE(PG8_SB(1, 0), cB + kstep, voffB); PG8_STAGE(PG8_SA(1, 0), cA + kstep, voffA); PG8_STAGE(PG8_SB(1, 1), cB + hstepB + kstep, voffB);
    PG8_WAIT_V(6); PG8_BAR;
    for (;;) {
        const bool has_next = S.next(ui + 1, nxt);
        const char* nA = cA; const char* nB = cB;
        for (int pass = 0; pass < npass; ++pass) {
        const bool lastpass = (pass == npass - 1);
        if (!lastpass) { nA = (const char*)g.A2 + (size_t)cur.pm * tstepA; nB = (const char*)g.Bt2 + (size_t)cur.pn * tstepB; }
        else if (has_next) { nA = (const char*)g.A + (size_t)nxt.pm * tstepA; nB = (const char*)g.Bt + (size_t)nxt.pn * tstepB; }
        else { nA = cA; nB = cB; }
        for (int t = 0; t < nt; t += 2) {
            const bool last = (t == nt - 2);
            const char* a1 = cA + (size_t)(t + 1) * kstep;
            const char* a2 = last ? nA : cA + (size_t)(t + 2) * kstep; const char* b2 = last ? nB : cB + (size_t)(t + 2) * kstep;
            const char* a3 = a2 + kstep; const char* b3 = b2 + kstep;
            PG8_LDB(B0, 0, 0); PG8_SCHED; PG8_LDA(At, 0, 0); PG8_STAGE(PG8_SA(1, 1), a1 + hstepA, voffA);
            PG8_WAIT_L(8); PG8_BAR; PG8_WAIT_L(0); PG8_MMA(0, 0, At, B0); PG8_BAR; PG8_SCHED;
            PG8_LDB(B1, 0, 1); PG8_STAGE(PG8_SB(0, 0), b2, voffB);
            PG8_BAR; PG8_WAIT_L(0); PG8_MMA(0, 1, At, B1); PG8_BAR;
            PG8_LDA(At, 0, 1); PG8_STAGE(PG8_SA(0, 0), a2, voffA);
            PG8_BAR; PG8_WAIT_L(0); PG8_MMA(1, 0, At, B0); PG8_BAR; PG8_SCHED;
            PG8_STAGE(PG8_SB(0, 1), b2 + hstepB, voffB);
            PG8_WAIT_V(6); PG8_BAR; PG8_MMA(1, 1, At, B1); PG8_BAR;
            PG8_LDB(B0, 1, 0); PG8_SCHED; PG8_LDA(At, 1, 0); PG8_STAGE(PG8_SA(0, 1), a2 + hstepA, voffA);
            PG8_WAIT_L(8); PG8_BAR; PG8_WAIT_L(0); PG8_MMA(0, 0, At, B0); PG8_BAR; PG8_SCHED;
            PG8_LDB(B1, 1, 1); PG8_STAGE(PG8_SB(1, 0), b3, voffB);
            PG8_BAR; PG8_WAIT_L(0); PG8_MMA(0, 1, At, B1); PG8_BAR;
            PG8_LDA(At, 1, 1); PG8_STAGE(PG8_SA(1, 0), a3, voffA);
            PG8_BAR; PG8_WAIT_L(0); PG8_MMA(1, 0, At, B0); PG8_BAR; PG8_SCHED;
            PG8_STAGE(PG8_SB(1, 1), b3 + hstepB, voffB);
            PG8_WAIT_V(6); PG8_BAR; PG8_MMA(1, 1, At, B1); PG8_BAR;
        }
        if (!lastpass) { E.mid(acc, cur, wr, wc, fr, fq); cA = nA; cB = nB; }
        }
        E(acc, cur, wr, wc, fr, fq);
        if (!has_next) break;
#pragma unroll
        for (int a = 0; a < 2; ++a)
#pragma unroll
            for (int b = 0; b < 2; ++b)
#pragma unroll
                for (int m = 0; m < 4; ++m)
#pragma unroll
                    for (int n = 0; n < 2; ++n) acc[a][b][m][n] = (f32x4){0.f, 0.f, 0.f, 0.f};
        cur = nxt; cA = nA; cB = nB; ++ui;
    }
    PG8_WAIT_V(0);
    if (wr == 0) PG8_BAR;
    PG8_BAR;
#undef PG8_SA
#undef PG8_SB
#undef PG8_STAGE
#undef PG8_LDA
#undef PG8_LDB
#undef PG8_MMA
#undef PG8_WAIT_V
#undef PG8_WAIT_L
#undef PG8_BAR
#undef PG8_SCHED
}
}

#define XB_TMO      128
#define XB_XCNT(j)  (256  + 64 * (j))
#define XB_XSUB(j)  (1280 + 64 * (j))
#define XB_XGEN(j)  (2304 + 64 * (j))
#define XB_TOP      3328
#define XB_TOPGEN   3392
#define XCD_BAR_WORDS 3456
#define XB_SPIN_CAP (1u << 18)

__device__ __forceinline__ unsigned xb_ld(unsigned* p)              { return __hip_atomic_load(p, __ATOMIC_RELAXED, __HIP_MEMORY_SCOPE_AGENT); }
__device__ __forceinline__ unsigned xb_add(unsigned* p, unsigned v) { return __hip_atomic_fetch_add(p, v, __ATOMIC_RELAXED, __HIP_MEMORY_SCOPE_AGENT); }
__device__ __forceinline__ unsigned xb_xcc_id() { return (unsigned)__builtin_amdgcn_s_getreg((3 << 11) | 20) & 0xFu; }
#define XB_SPIN(cond, bar) do { unsigned _sp = 0; while (cond) { __builtin_amdgcn_s_sleep(1); \
    if ((++_sp & 255u) == 0u) { if (xb_ld(&(bar)[XB_TMO])) break; if (_sp > XB_SPIN_CAP) { atomicAdd(&(bar)[XB_TMO], 1u); break; } } } } while (0)

struct XcdBarrier {
    unsigned* bar; unsigned x;
    volatile LAS unsigned* st;
};

__device__ __forceinline__ XcdBarrier xcd_barrier_post(unsigned* bar, volatile LAS unsigned* st) {
    XcdBarrier b; b.bar = bar; b.x = xb_xcc_id(); b.st = st;
    if (threadIdx.x == 0) (void)xb_add(&bar[XB_XCNT(b.x)], 1u);
    return b;
}
__device__ __forceinline__ void xcd_barrier_complete(unsigned* bar, unsigned x, unsigned& nloc, unsigned& nx) {
    const unsigned G = gridDim.x * gridDim.y * gridDim.z;
    unsigned sum, cnt, mine, sp = 0u;
    for (;;) {
        sum = 0u; cnt = 0u; mine = 0u;
#pragma unroll
        for (unsigned j = 0; j < 16; ++j) { const unsigned c = xb_ld(&bar[XB_XCNT(j)]); sum += c; cnt += (c > 0u) ? 1u : 0u; mine = (j == x) ? c : mine; }
        if (sum == G) break;
        __builtin_amdgcn_s_sleep(1);
        if ((++sp & 255u) == 0u) { if (xb_ld(&bar[XB_TMO])) break; if (sp > XB_SPIN_CAP) { atomicAdd(&bar[XB_TMO], 1u); break; } }
    }
    nloc = mine > 0u ? mine : 1u; nx = cnt > 0u ? cnt : 1u;
}

__device__ __forceinline__ void xcd_barrier(const XcdBarrier& b) {
    asm volatile("s_waitcnt vmcnt(0)" ::: "memory");
    __syncthreads();
    if (threadIdx.x == 0) {
        unsigned* bar = b.bar;
        __builtin_amdgcn_s_waitcnt(0);
        unsigned nloc = b.st[0], nx = b.st[1];
        if (nloc == 0u) { xcd_barrier_complete(bar, b.x, nloc, nx); b.st[0] = nloc; b.st[1] = nx; }
        const unsigned old = xb_add(&bar[XB_XSUB(b.x)], 1u);
        const unsigned gen = old / nloc;
        if (old + 1u == (gen + 1u) * nloc) {
            __builtin_amdgcn_fence(__ATOMIC_RELEASE, "agent");
            asm volatile("s_waitcnt vmcnt(0)" ::: "memory");
            const unsigned og = xb_add(&bar[XB_TOP], 1u);
            const unsigned tg = og / nx;
            if (og + 1u == (tg + 1u) * nx) xb_add(&bar[XB_TOPGEN], 1u);
            else XB_SPIN(xb_ld(&bar[XB_TOPGEN]) == tg, bar);
            __builtin_amdgcn_fence(__ATOMIC_ACQUIRE, "agent");
            xb_add(&bar[XB_XGEN(b.x)], 1u);
            asm volatile("s_waitcnt vmcnt(0)" ::: "memory");
        } else {
            XB_SPIN(xb_ld(&bar[XB_XGEN(b.x)]) == gen, bar);
            __builtin_amdgcn_fence(__ATOMIC_ACQUIRE, "agent");
            asm volatile("s_waitcnt vmcnt(0)" ::: "memory");
        }
    }
    __syncthreads();
}


__device__ __forceinline__ void subset_barrier(unsigned* ctr, unsigned target) {
    asm volatile("s_waitcnt vmcnt(0)" ::: "memory");
    __syncthreads();
    if (threadIdx.x == 0) {
        __builtin_amdgcn_fence(__ATOMIC_RELEASE, "agent");
        asm volatile("s_waitcnt vmcnt(0)" ::: "memory");
        (void)xb_add(ctr, 1u);
        unsigned sp = 0u;
        while (xb_ld(ctr) < target) { __builtin_amdgcn_s_sleep(2); if (++sp > (1u << 22)) break; }
        __builtin_amdgcn_fence(__ATOMIC_ACQUIRE, "agent");
        asm volatile("s_waitcnt vmcnt(0)" ::: "memory");
    }
    __syncthreads();
}

__device__ __forceinline__ int rope_pos(int g, int row) { const int gr = grow(g, row); return gr < NPTOK ? (gr & 4095) : ((gr - NPTOK) & 8191); }
struct EpiAll {
    static constexpr bool PERM = true;
    int mode;
    bf16_t* O; const bf16_t* proj; const float* bias;
    const float* xp; const float* xs; float* out; int g, layer;
    const float* lbp; const float2* rope;
    __device__ __forceinline__ void mid(f32x4 (&acc)[2][2][4][2], const pg8::Unit& u, int wr, int wc, int fr_in, int fq_in) const {
        int fr = fr_in, fq = fq_in; asm volatile("" : "+v"(fr), "+v"(fq));
        const int row0 = u.pm * 256 + wr * 64 + fr, col0 = u.pn * 256 + wc * 32 + 8 * fq;
#pragma unroll
        for (int i = 0; i < 16; ++i) { const int ai = i >> 3, m = (i >> 1) & 3, bj = i & 1; const int n = col0 + bj * 128;
            const u32x4 gq = *(const u32x4*)(proj + (size_t)(row0 + ai * 128 + m * 16) * NC1 + C_MG + (n >> 7) * 256 + (n & 127));
            acc[ai][bj][m][0][0] *= bf_lo(gq.x); acc[ai][bj][m][0][1] *= bf_hi(gq.x); acc[ai][bj][m][0][2] *= bf_lo(gq.y); acc[ai][bj][m][0][3] *= bf_hi(gq.y);
            acc[ai][bj][m][1][0] *= bf_lo(gq.z); acc[ai][bj][m][1][1] *= bf_hi(gq.z); acc[ai][bj][m][1][2] *= bf_lo(gq.w); acc[ai][bj][m][1][3] *= bf_hi(gq.w); }
    }
    __device__ __forceinline__ void operator()(const f32x4 (&acc)[2][2][4][2], const pg8::Unit& u, int wr, int wc, int fr_in, int fq_in) const {
        int fr = fr_in, fq = fq_in; asm volatile("" : "+v"(fr), "+v"(fq));
        const int row0 = u.pm * 256 + wr * 64 + fr, col0 = u.pn * 256 + wc * 32 + 8 * fq;
        if (mode == 0) {
            const int pn = u.pn;
            const int kind = (pn < 4) ? 1 : (pn < 12) ? 2 : (pn < 20) ? 0 : (pn < 24) ? 4 : (pn < 32) ? 0 : 5;
            f32x4 den[2][4][2];
#pragma unroll
            for (int bj = 0; bj < 2; ++bj) {
                const int col = col0 + bj * 128;
                f32x4 b0 = (f32x4){0.f, 0.f, 0.f, 0.f}, b1 = b0, c0 = (f32x4){1.f, 1.f, 1.f, 1.f}, c1 = c0;
                if (kind == 5) { const int nb = (pn - 32) * 128 + wc * 32 + 8 * fq + bj * 1024; b0 = *(const f32x4*)(bias + nb); b1 = *(const f32x4*)(bias + nb + 4); }
                if (kind == 2) {
                    if (layer == 1) { const int ch = col & 1023;
                        const f32x4 a0 = *(const f32x4*)(lbp + ch), a1 = *(const f32x4*)(lbp + ch + 4), d0 = *(const f32x4*)(lbp + 1024 + ch), d1 = *(const f32x4*)(lbp + 1024 + ch + 4);
#pragma unroll
                        for (int j = 0; j < 4; ++j) { const float l0 = sigmoidf_(d0[j] - a0[j]), l1 = sigmoidf_(d1[j] - a1[j]);
                            b0[j] = fmaxf(l0, 1e-30f); b1[j] = fmaxf(l1, 1e-30f); c0[j] = 1.0f - l0; c1[j] = 1.0f - l1; } }
                    else { b0 = (f32x4){1e-30f, 1e-30f, 1e-30f, 1e-30f}; b1 = b0; } }
                f32x4 rr0[4], rr1[4];
#define ROPE_PTR(idx) ((const f32x4*)(rope + (size_t)rope_pos(g, row0 + (((idx) >> 2) & 1) * 128 + ((idx) & 3) * 16) * 32 + ((col & 63) >> 1)))
                if (kind == 4) {
#pragma unroll
                    for (int k = 0; k < 4; ++k) { const f32x4* rp = ROPE_PTR(k); rr0[k] = rp[0]; rr1[k] = rp[1]; } }
#pragma unroll
                for (int ai = 0; ai < 2; ++ai)
#pragma unroll
                    for (int m = 0; m < 4; ++m) { f32x4 v0 = acc[ai][bj][m][0], v1 = acc[ai][bj][m][1];
                        const int row = row0 + ai * 128 + m * 16;
                        if (kind == 1) {
#pragma unroll
                            for (int j = 0; j < 4; ++j) { v0[j] = v0[j] * sigmoidf_(v0[j]) * 0.08838834764831845f; v1[j] = v1[j] * sigmoidf_(v1[j]) * 0.08838834764831845f; }
                        } else if (kind == 2) {
#pragma unroll
                            for (int j = 0; j < 4; ++j) { const float x0 = fminf(fmaxf(v0[j], -30.f), 30.f), x1 = fminf(fmaxf(v1[j], -30.f), 30.f);
                                v0[j] = __builtin_amdgcn_logf(b0[j] + c0[j] * sigmoidf_(x0)); v1[j] = __builtin_amdgcn_logf(b1[j] + c1[j] * sigmoidf_(x1)); }
                        } else if (kind == 3) {
#pragma unroll
                            for (int j = 0; j < 4; ++j) { v0[j] = v0[j] * sigmoidf_(v0[j]); v1[j] = v1[j] * sigmoidf_(v1[j]); }
                        } else if (kind == 4) {
                            const int idx = ai * 4 + m;
                            const f32x4 r0 = rr0[idx & 3], r1 = rr1[idx & 3]; const float qs = (pn < 22) ? 0.125f : 1.0f;
                            if (idx + 4 < 8) { const f32x4* rp = ROPE_PTR(idx + 4); rr0[idx & 3] = rp[0]; rr1[idx & 3] = rp[1]; }
                            f32x4 w0, w1;
                            w0[0] = (v0[0] * r0[0] - v0[1] * r0[1]) * qs; w0[1] = (v0[0] * r0[1] + v0[1] * r0[0]) * qs; w0[2] = (v0[2] * r0[2] - v0[3] * r0[3]) * qs; w0[3] = (v0[2] * r0[3] + v0[3] * r0[2]) * qs;
                            w1[0] = (v1[0] * r1[0] - v1[1] * r1[1]) * qs; w1[1] = (v1[0] * r1[1] + v1[1] * r1[0]) * qs; w1[2] = (v1[2] * r1[2] - v1[3] * r1[3]) * qs; w1[3] = (v1[2] * r1[3] + v1[3] * r1[2]) * qs;
                            v0 = w0; v1 = w1;
                        } else if (kind == 5) {
                            v0 += b0; v1 += b1;
#pragma unroll
                            for (int j = 0; j < 4; ++j) { v0[j] = 1.0f + exp2_(-1.4426950408889634f * v0[j]); v1[j] = 1.0f + exp2_(-1.4426950408889634f * v1[j]); }
                            if (bj == 0) { den[ai][m][0] = v0; den[ai][m][1] = v1; continue; }
                            f32x4 s0, s1, q0, q1;
#pragma unroll
                            for (int j = 0; j < 4; ++j) { s0[j] = rcp_(v0[j]); s1[j] = rcp_(v1[j]); q0[j] = v0[j] * rcp_(den[ai][m][0][j]); q1[j] = v1[j] * rcp_(den[ai][m][1][j]); }
                            u32x4 wq; wq.x = cvt_pk_bf16(q0[0], q0[1]); wq.y = cvt_pk_bf16(q0[2], q0[3]); wq.z = cvt_pk_bf16(q1[0], q1[1]); wq.w = cvt_pk_bf16(q1[2], q1[3]);
                            *(u32x4*)(O + (size_t)row * NC1 + col - 128) = wq;
                            v0 = s0; v1 = s1; }
                        u32x4 w; w.x = cvt_pk_bf16(v0[0], v0[1]); w.y = cvt_pk_bf16(v0[2], v0[3]); w.z = cvt_pk_bf16(v1[0], v1[1]); w.w = cvt_pk_bf16(v1[2], v1[3]);
                        *(u32x4*)(O + (size_t)row * NC1 + col) = w;
                        } }
        } else if (mode == 3) {
            const int gr0 = grow(g, u.pm * 256), s = seq_of(gr0);
            const float* xb = layer ? (const float*)out + (size_t)gr0 * 1024 : (gr0 < NPTOK ? xp + (size_t)gr0 * 1024 : xs + (size_t)(gr0 - NPTOK) * 1024);
            float* ob = out + (size_t)gr0 * 1024;
            const int rl0 = wr * 64 + fr;
            f32x4 gv[2][2];
#pragma unroll
            for (int bj = 0; bj < 2; ++bj) { gv[bj][0] = *(const f32x4*)(bias + s * 3072 + 2048 + col0 + bj * 128) + 1.0f; gv[bj][1] = *(const f32x4*)(bias + s * 3072 + 2048 + col0 + bj * 128 + 4) + 1.0f; }
            f32x4 xr[4][2];
#define E3_OFF(i) ((size_t)(rl0 + ((i) >> 3) * 128 + (((i) >> 1) & 3) * 16) * 1024 + col0 + ((i) & 1) * 128)
#pragma unroll
            for (int k = 0; k < 4; ++k) { xr[k][0] = *(const f32x4*)(xb + E3_OFF(k)); xr[k][1] = *(const f32x4*)(xb + E3_OFF(k) + 4); }
#pragma unroll
            for (int i = 0; i < 16; ++i) {
                const f32x4 x0 = xr[i & 3][0], x1 = xr[i & 3][1];
                if (i + 4 < 16) { xr[i & 3][0] = *(const f32x4*)(xb + E3_OFF(i + 4)); xr[i & 3][1] = *(const f32x4*)(xb + E3_OFF(i + 4) + 4); }
                const int ai = i >> 3, m = (i >> 1) & 3, bj = i & 1;
                *(f32x4*)(ob + E3_OFF(i)) = x0 * DN_ALPHA + gv[bj][0] * acc[ai][bj][m][0]; *(f32x4*)(ob + E3_OFF(i) + 4) = x1 * DN_ALPHA + gv[bj][1] * acc[ai][bj][m][1];
            }
#undef E3_OFF
        } else {
            u32x4 gr[6];
#define E2_ROW(i) ((size_t)(row0 + ((i) >> 3) * 128 + (((i) >> 1) & 3) * 16))
#define E2_COL(i) (col0 + ((i) & 1) * 128)
#define E2_G(i) (C_MG + (E2_COL(i) >> 7) * 256 + 128 + (E2_COL(i) & 127))
#pragma unroll
            for (int k = 0; k < 6; ++k) gr[k] = *(const u32x4*)(proj + E2_ROW(k) * NC1 + E2_G(k));
#pragma unroll
            for (int i = 0; i < 16; ++i) {
                const u32x4 ga = gr[i % 6];
                if (i + 6 < 16) gr[i % 6] = *(const u32x4*)(proj + E2_ROW(i + 6) * NC1 + E2_G(i + 6));
                const int ai = i >> 3, m = (i >> 1) & 3, bj = i & 1;
                f32x4 v0 = acc[ai][bj][m][0], v1 = acc[ai][bj][m][1];
                v0[0] *= bf_lo(ga.x); v0[1] *= bf_hi(ga.x); v0[2] *= bf_lo(ga.y); v0[3] *= bf_hi(ga.y);
                v1[0] *= bf_lo(ga.z); v1[1] *= bf_hi(ga.z); v1[2] *= bf_lo(ga.w); v1[3] *= bf_hi(ga.w);
                u32x4 w; w.x = cvt_pk_bf16(v0[0], v0[1]); w.y = cvt_pk_bf16(v0[2], v0[3]); w.z = cvt_pk_bf16(v1[0], v1[1]); w.w = cvt_pk_bf16(v1[2], v1[3]);
                *(u32x4*)(O + E2_ROW(i) * 1024 + E2_COL(i)) = w;
            }
#undef E2_ROW
#undef E2_COL
#undef E2_G
        }
    }
};

__device__ __forceinline__ void phase_init(const Params& p, LAS unsigned char* lds) {
    int tid_ = threadIdx.x; asm volatile("" : "+v"(tid_));
    const int tid = tid_, nb = gridDim.x, b = blockIdx.x;
    LAS float* tile = (LAS float*)lds;
    for (int u = b; u < 2 * 208 * 16; u += nb) {
        const int l = u / (208 * 16), rem = u % (208 * 16), ntile = rem >> 4, kt = rem & 15;
        const float* src; int ldsrc, ncol0; bf16_t* dst;
        if (ntile < 128)      { src = p.w_in + (size_t)l * 1024 * 8192; ldsrc = 8192; ncol0 = ntile * 64;         dst = (bf16_t*)(p.ws + WS_WT1) + ((size_t)l * 10240 + ncol0) * 1024; }
        else if (ntile < 160) { src = p.w_mg + (size_t)l * 1024 * 2048; ldsrc = 2048; ncol0 = (ntile - 128) * 64; dst = (bf16_t*)(p.ws + WS_WT1) + ((size_t)l * 10240 + 8192 + ncol0) * 1024; }
        else if (ntile < 176) { src = p.w_pa + (size_t)l * 1024 * 1024; ldsrc = 1024; ncol0 = (ntile - 160) * 64; dst = (bf16_t*)(p.ws + WS_WPA) + ((size_t)l * 1024 + ncol0) * 1024; }
        else if (ntile < 192) { src = p.w_pb + (size_t)l * 1024 * 1024; ldsrc = 1024; ncol0 = (ntile - 176) * 64; dst = (bf16_t*)(p.ws + WS_WPB) + ((size_t)l * 1024 + ncol0) * 1024; }
        else                  { src = p.w_out + (size_t)l * 1024 * 1024; ldsrc = 1024; ncol0 = (ntile - 192) * 64; dst = (bf16_t*)(p.ws + WS_WOUT) + ((size_t)l * 1024 + ncol0) * 1024; }
        const int k0 = kt * 64;
        { const int kr = tid >> 3, c8 = (tid & 7) * 8; const float* s = src + (size_t)(k0 + kr) * ldsrc + ncol0 + c8;
          const f32x4 a = *(const f32x4*)s, c = *(const f32x4*)(s + 4);
#pragma unroll
          for (int j = 0; j < 4; ++j) { tile[kr * 65 + c8 + j] = a[j]; tile[kr * 65 + c8 + 4 + j] = c[j]; } }
        __syncthreads();
        { const int n = tid >> 3, kg = (tid & 7) * 8; float v[8];
#pragma unroll
          for (int j = 0; j < 8; ++j) v[j] = tile[(kg + j) * 65 + n];
          u32x4 w; w.x = cvt_pk_bf16(v[0], v[1]); w.y = cvt_pk_bf16(v[2], v[3]); w.z = cvt_pk_bf16(v[4], v[5]); w.w = cvt_pk_bf16(v[6], v[7]);
          int np = n;
          if (ntile >= 80 && ntile < 96) np = ((n & 31) << 1) | (n >> 5);
          if (ntile >= 128 && ntile < 160) { const int L = (ntile - 128) * 64 + n, which = L >> 10, nn = L & 1023; np = (nn >> 7) * 256 + which * 128 + (nn & 127) - (ntile - 128) * 64; }
          *(u32x4*)(dst + (ptrdiff_t)np * 1024 + k0 + kg) = w; }
        __syncthreads();
    }
    float* adap = (float*)(p.ws + WS_PROJ);
    for (int u = b; u < 96; u += nb) {
        const int cb = u % 6, ks = (u / 6) % 8, l = u / 48;
        __syncthreads();
        for (int e = tid; e < 18 * 128; e += 512) { const int s = e >> 7, k = e & 127;
            const float c = (s < 16) ? p.c_prompt[s * 1024 + ks * 128 + k] : p.c_sample[(s - 16) * 1024 + ks * 128 + k];
            tile[e] = c / (1.0f + __expf(-c)); }
        __syncthreads();
        const int n = cb * 512 + tid; float acc[18];
#pragma unroll
        for (int s = 0; s < 18; ++s) acc[s] = 0.f;
        const float* w = p.w_ada + (size_t)l * 1024 * 3072 + (size_t)(ks * 128) * 3072 + n;
#pragma unroll 4
        for (int k = 0; k < 128; ++k) { const float wv = w[(size_t)k * 3072];
#pragma unroll
            for (int s = 0; s < 18; ++s) acc[s] += tile[s * 128 + k] * wv; }
#pragma unroll
        for (int s = 0; s < 18; ++s) adap[(size_t)((ks * 2 + l) * 18 + s) * 3072 + n] = acc[s];
    }
    float2* rope = (float2*)(p.ws + WS_ROPE);
    for (int e = b * 512 + tid; e < 8192 * 32; e += nb * 512) {
        const int pos = e >> 5, i = e & 31;
        double inv = 1.0; for (int k = 0; k < i; ++k) inv *= 0.7498942093324559;
        const double rev = (double)pos * inv * 0.15915494309189533577;
        double fr = rev - floor(rev); if (fr > 0.5) fr -= 1.0;
        const double r = fr * 6.28318530717958647692, r2 = r * r;
        double s = 1.0, c = 1.0;
#pragma unroll
        for (int n = 13; n >= 1; --n) { s = 1.0 - s * r2 * (1.0 / (double)((2 * n) * (2 * n + 1))); c = 1.0 - c * r2 * (1.0 / (double)((2 * n - 1) * (2 * n))); }
        rope[e] = make_float2((float)c, (float)(s * r));
    }
}

__device__ __forceinline__ void phase_ada_fin(const Params& p) {
    const float* adap = (const float*)(p.ws + WS_PROJ); float* ada = (float*)(p.ws + WS_ADA);
    int tid_ = threadIdx.x; asm volatile("" : "+v"(tid_));
    for (int e = blockIdx.x * 512 + tid_; e < 2 * 18 * 3072; e += gridDim.x * 512) {
        const int l = e / (18 * 3072), n = e % 3072; float a = p.b_ada[l * 3072 + n];
#pragma unroll
        for (int ks = 0; ks < 8; ++ks) a += adap[(size_t)ks * 110592 + e];
        ada[e] = a;
    }
}

__device__ __forceinline__ void phase_prep(const Params& p, int l, int g) {
    int tid_ = threadIdx.x; asm volatile("" : "+v"(tid_));
    const int tid = tid_; const float* ada = (const float*)(p.ws + WS_ADA) + l * 18 * 3072;
    unsigned* U32 = (unsigned*)(p.ws + WS_U);
    for (int strip = blockIdx.x; strip < MG / 16; strip += gridDim.x) {
        const int r0 = strip * 16, gr0 = grow(g, r0), s = seq_of(gr0);
        const float* src = l ? (const float*)p.out + (size_t)gr0 * 1024 : (gr0 < NPTOK ? p.x_prompt + (size_t)gr0 * 1024 : p.x_sample + (size_t)(gr0 - NPTOK) * 1024);
        const float2 sh = *(const float2*)(ada + s * 3072 + 2 * tid), sc = *(const float2*)(ada + s * 3072 + 1024 + 2 * tid);
#pragma unroll 8
        for (int i = 0; i < 16; ++i) { const f32x2 xv = l ? *(const f32x2*)(src + (size_t)i * 1024 + 2 * tid) : __builtin_nontemporal_load((const f32x2*)(src + (size_t)i * 1024 + 2 * tid)); const float2 x = make_float2(xv.x, xv.y);
            U32[(size_t)(r0 + i) * 512 + tid] = cvt_pk_bf16(x.x * (1.0f + sc.x) + sh.x, x.y * (1.0f + sc.y) + sh.y); }
    }
}

__device__ __forceinline__ void ln_row(float* row, const f32x4 (&vin)[4], const float* gam, const float* bet, int lane, const float* ada_next, unsigned* urow) {
    f32x4 v[4]; float s = 0.f;
#pragma unroll
    for (int i = 0; i < 4; ++i) { v[i] = vin[i]; s += (v[i][0] + v[i][1]) + (v[i][2] + v[i][3]); }
#pragma unroll
    for (int o = 32; o >= 1; o >>= 1) s += __shfl_xor(s, o);
    const float mu = s * (1.0f / 1024.0f); float q = 0.f;
#pragma unroll
    for (int i = 0; i < 4; ++i) { v[i] -= mu; q += (v[i][0] * v[i][0] + v[i][1] * v[i][1]) + (v[i][2] * v[i][2] + v[i][3] * v[i][3]); }
#pragma unroll
    for (int o = 32; o >= 1; o >>= 1) q += __shfl_xor(q, o);
    const float rstd = 1.0f / sqrtf(q * (1.0f / 1024.0f) + LN_EPS);
#pragma unroll
    for (int i = 0; i < 4; ++i) { const f32x4 gm = *(const f32x4*)(gam + i * 256 + lane * 4), bt = *(const f32x4*)(bet + i * 256 + lane * 4);
        const f32x4 y = v[i] * rstd * gm + bt;
        if (ada_next) *(f32x4*)(row + i * 256 + lane * 4) = y; else __builtin_nontemporal_store(y, (f32x4*)(row + i * 256 + lane * 4));
        if (ada_next) { const f32x4 sh = *(const f32x4*)(ada_next + i * 256 + lane * 4), sc = *(const f32x4*)(ada_next + 1024 + i * 256 + lane * 4); const f32x4 uu = y * (sc + 1.0f) + sh;
            u32x2 pk; pk.x = cvt_pk_bf16(uu[0], uu[1]); pk.y = cvt_pk_bf16(uu[2], uu[3]); *(u32x2*)(urow + i * 128 + lane * 2) = pk; } }
}
__device__ __forceinline__ void phase_ln(const Params& p, int l, int g, bool emit_u) {
    int tid_ = threadIdx.x; asm volatile("" : "+v"(tid_));
    const int lane = tid_ & 63, wv = tid_ >> 6;
    const float* gam = p.ln_g + l * 1024; const float* bet = p.ln_b + l * 1024;
    const int stride = gridDim.x * 8;
    for (int r = blockIdx.x * 8 + wv; r < MG; r += 4 * stride) {
        float* rows[4]; f32x4 v[4][4];
#pragma unroll
        for (int k = 0; k < 4; ++k) { const int rr = r + k * stride; rows[k] = p.out + (size_t)grow(g, rr < MG ? rr : r) * 1024;
#pragma unroll
            for (int i = 0; i < 4; ++i) v[k][i] = __builtin_nontemporal_load((const f32x4*)(rows[k] + i * 256 + lane * 4)); }
#pragma unroll
        for (int k = 0; k < 4; ++k) if (r + k * stride < MG) { const int rr = r + k * stride; const int sq = seq_of(grow(g, rr));
            ln_row(rows[k], v[k], gam, bet, lane, emit_u ? (const float*)(p.ws + WS_ADA) + (l + 1) * 18 * 3072 + sq * 3072 : nullptr, (unsigned*)(p.ws + WS_U) + (size_t)rr * 512); }
    }
}

struct CombIn { u32x4 a, b, g; };
__device__ __forceinline__ void comb_ptrs(const Params& p, int u, int sub, const bf16_t*& pf, const bf16_t*& pb, bf16_t*& pg) {
    bf16_t* proj = (bf16_t*)(p.ws + WS_PROJ); const bf16_t* of_r = (const bf16_t*)(p.ws + WS_U); const bf16_t* ob_r = (const bf16_t*)(p.ws + WS_OB);
    const int r = u >> 4, mh = u & 15; const bool isA = mh < 8; const int h = mh & 7;
    pf = isA ? proj + (size_t)r * NC1 + C_AFF + h * 128 + sub * 8 : of_r + (size_t)r * 1024 + h * 128 + sub * 8;
    pb = isA ? proj + (size_t)r * NC1 + C_AFB + h * 128 + sub * 8 : ob_r + (size_t)r * 1024 + h * 128 + sub * 8;
    pg = proj + (size_t)r * NC1 + (isA ? C_AG : C_RG) + h * 128 + sub * 8;
}
__device__ __forceinline__ void comb_unit(const CombIn& in, bool isA, const f32x4& nw0, const f32x4& nw1, bf16_t* pg) {
    const u32x4 a = in.a, bq = in.b, gq = in.g;
    float o[8], gt[8];
    o[0] = bf_lo(a.x) + bf_lo(bq.x); o[1] = bf_hi(a.x) + bf_hi(bq.x); o[2] = bf_lo(a.y) + bf_lo(bq.y); o[3] = bf_hi(a.y) + bf_hi(bq.y);
    o[4] = bf_lo(a.z) + bf_lo(bq.z); o[5] = bf_hi(a.z) + bf_hi(bq.z); o[6] = bf_lo(a.w) + bf_lo(bq.w); o[7] = bf_hi(a.w) + bf_hi(bq.w);
    gt[0] = bf_lo(gq.x); gt[1] = bf_hi(gq.x); gt[2] = bf_lo(gq.y); gt[3] = bf_hi(gq.y); gt[4] = bf_lo(gq.z); gt[5] = bf_hi(gq.z); gt[6] = bf_lo(gq.w); gt[7] = bf_hi(gq.w);
    if (!isA) { float s = 0.f;
#pragma unroll
        for (int j = 0; j < 8; ++j) s += o[j];
        s += __shfl_xor(s, 1); s += __shfl_xor(s, 2); s += __shfl_xor(s, 4); s += __shfl_xor(s, 8);
        const float mu = s * (1.0f / 128.0f);
#pragma unroll
        for (int j = 0; j < 8; ++j) o[j] -= mu; }
    float q = 0.f;
#pragma unroll
    for (int j = 0; j < 8; ++j) q += o[j] * o[j];
    q += __shfl_xor(q, 1); q += __shfl_xor(q, 2); q += __shfl_xor(q, 4); q += __shfl_xor(q, 8);
    const float rs = 1.0f / sqrtf(q * (1.0f / 128.0f) + LN_EPS);
    float y[8];
#pragma unroll
    for (int j = 0; j < 8; ++j) { const float wn = isA ? (j < 4 ? nw0[j & 3] : nw1[j & 3]) : 1.0f; y[j] = o[j] * rs * wn * gt[j] * sigmoidf_(gt[j]); }
    u32x4 w; w.x = cvt_pk_bf16(y[0], y[1]); w.y = cvt_pk_bf16(y[2], y[3]); w.z = cvt_pk_bf16(y[4], y[5]); w.w = cvt_pk_bf16(y[6], y[7]);
    *(u32x4*)pg = w;
}
__device__ __forceinline__ void phase_comb(const Params& p, int l, int row_lo, int nrows, int nb, int bi) {
    int tid_ = threadIdx.x; asm volatile("" : "+v"(tid_));
    const int tid = tid_, sub = tid & 15;
    const f32x4 nw0 = *(const f32x4*)(p.a_norm_w + l * 128 + sub * 8), nw1 = *(const f32x4*)(p.a_norm_w + l * 128 + sub * 8 + 4);
    const int ngrp = nb * 32, total = (row_lo + nrows) * 16;
    for (int u = row_lo * 16 + ((bi * 512 + tid) >> 4); u < total; u += 4 * ngrp) {
        CombIn in[4]; bf16_t* pg[4];
#pragma unroll
        for (int k = 0; k < 4; ++k) { const int uu = (u + k * ngrp < total) ? u + k * ngrp : u; const bf16_t* pf; const bf16_t* pb; comb_ptrs(p, uu, sub, pf, pb, pg[k]);
            in[k].a = __builtin_nontemporal_load((const u32x4*)pf); in[k].b = __builtin_nontemporal_load((const u32x4*)pb); in[k].g = __builtin_nontemporal_load((const u32x4*)pg[k]); }
#pragma unroll
        for (int k = 0; k < 4; ++k) if (u + k * ngrp < total) comb_unit(in[k], (u & 15) < 8, nw0, nw1, pg[k]);
    }
}

__device__ __forceinline__ bf16x8 ldfrag(const LAS unsigned char* base, int pitch, int tile, int ks, int fr, int fq) {
    return *(const LAS bf16x8*)(base + (tile * 16 + fr) * pitch + (ks * 32 + fq * 8) * 2);
}
#define LDS_BARRIER() do { asm volatile("s_waitcnt lgkmcnt(0)" ::: "memory"); __builtin_amdgcn_s_barrier(); asm volatile("" ::: "memory"); } while (0)
#define MFMA16(a, b, c) __builtin_amdgcn_mfma_f32_16x16x32_bf16((a), (b), (c), 0, 0, 0)

constexpr int MIX_LDS_MAX = 139264;
template <int DK, bool IS_A, int NDV>
__device__ __forceinline__ void mix_stream(const Params& p, LAS unsigned char* lds, int l, int rs, int T, int h, int dir, int dvh) {
    constexpr int QP = (DK + 8) * 2, TP = 144, KS = DK / 32;
    static_assert(NDV == 8, "tile ownership below is written for all 128 value channels");
    constexpr int DVW = IS_A ? 4 : 2;
    constexpr int NTV = 2 * DVW, NO = NDV / 2;
    constexpr int OFF_Q = 0, OFF_K = OFF_Q + 64 * QP, OFF_VT = OFF_K + 64 * QP, OFF_KT = OFF_VT + 128 * TP, OFF_ST = OFF_KT + DK * TP, OFF_P = OFF_ST + 128 * QP,
                  OFF_SEG = OFF_P + 64 * TP, OFF_CDEC = OFF_SEG + 8 * DK * 4, OFF_CSC = OFF_CDEC + DK * 4, OFF_O = OFF_CSC + DK * 4, OP = 272;
    static_assert(OFF_O + 64 * OP <= MIX_LDS_MAX, "mixer LDS");
    int tid_ = threadIdx.x; asm volatile("" : "+v"(tid_));
    const int tid = tid_, lane = tid & 63, w = __builtin_amdgcn_readfirstlane(tid >> 6), fr = lane & 15, fq = lane >> 4, cp = lane, sg = w;
    const int gx = ((fr + 4) >> 3) & 1, fqx = fq ^ gx, gk = ((((2 * cp) & 15) + 4) >> 3) & 1, sgx = (sg & 1) << 4;
    LAS unsigned char* Qs = lds + OFF_Q; LAS unsigned char* Ks = lds + OFF_K; LAS unsigned char* Vt = lds + OFF_VT; LAS unsigned char* Kt = lds + OFF_KT;
    LAS unsigned char* St = lds + OFF_ST; LAS unsigned char* Ps = lds + OFF_P; LAS unsigned char* Os = lds + OFF_O;
    LAS float* seg = (LAS float*)(lds + OFF_SEG); LAS float* cdec = (LAS float*)(lds + OFF_CDEC); LAS float* csc = (LAS float*)(lds + OFF_CSC);
    const bf16_t* proj = (const bf16_t*)(p.ws + WS_PROJ);
    const int N = T >> 6;
    const int cq = IS_A ? (C_AQ + h * 128) : (C_RQ + h * 64);
    const int cf = IS_A ? ((dir ? C_AFB : C_AFF) + h * 128) : (C_RK + h * 64);
    const int cv = (IS_A ? (C_AI + h * 128) : (C_RV + h * 128)) + dvh * 64;
    bf16_t* obase; int opitch, ocol;
    if (IS_A) { obase = (bf16_t*)(p.ws + WS_PROJ); opitch = NC1; ocol = (dir ? C_AFB : C_AFF) + h * 128 + dvh * 64; }
    else { obase = (bf16_t*)(p.ws + (dir ? WS_OB : WS_U)); opitch = 1024; ocol = h * 128 + dvh * 64; }
    float lg = 0.f;
    if (!IS_A) { const float x = p.ret_decay[l * 16 + dir * 8 + h]; lg = -log1pf(expf(-x)); }
    const int tdk0 = IS_A ? 2 * (w & 3) : 2 * (w & 1), tdv0 = IS_A ? (w >> 2) * 4 : (w >> 1) * 2;

    f32x4 S[NTV], U[NTV];
#pragma unroll
    for (int i = 0; i < NTV; ++i) { S[i] = (f32x4){0.f, 0.f, 0.f, 0.f}; U[i] = (f32x4){0.f, 0.f, 0.f, 0.f}; }
    unsigned rq[2][8], rv[2][8], rf[2][8];
    unsigned vo[8];
#pragma unroll
    for (int i = 0; i < 8; ++i) { const int t = sg * 8 + i; vo[i] = (unsigned)((dir ? 63 - t : t) * (NC1 * 2)); }
    const unsigned cqk_b = IS_A ? (unsigned)(cq * 2 + 4 * cp) : (unsigned)((cp < 32 ? cq : cf) * 2 + 4 * (cp & 31));
    const unsigned cf_b = (unsigned)(cf * 2 + 4 * cp), cv_b = (unsigned)(cv * 2 + 4 * cp);
#define MIX_RB(nn) (rs + (dir ? T - 64 - (nn) * 64 : (nn) * 64))
#define MIX_LOAD(nn, pp) do { const char* cb = (const char*)proj + (size_t)MIX_RB(nn) * (NC1 * 2); \
        _Pragma("unroll") for (int i = 0; i < 8; ++i) { \
        rq[pp][i] = *(const unsigned*)(cb + (vo[i] + cqk_b)); \
        if (IS_A) rf[pp][i] = *(const unsigned*)(cb + (vo[i] + cf_b)); \
        if (NDV == 8 || cp < 32) rv[pp][i] = *(const unsigned*)(cb + (vo[i] + cv_b)); } } while (0)
    const unsigned fo = (unsigned)((dir ? 63 - (tid >> 3) : (tid >> 3)) * opitch * 2 + (ocol + (tid & 7) * (NDV == 8 ? 16 : 8)) * 2);
#define MIX_FLUSH(nn) do { char* ob_ = (char*)obase + (size_t)MIX_RB(nn) * (opitch * 2) + fo; \
        if (NDV == 8) { const LAS unsigned char* src = Os + (tid >> 3) * OP + (tid & 7) * 32; \
            const u32x4 v0 = *(const LAS u32x4*)src, v1 = *(const LAS u32x4*)(src + 16); *(u32x4*)ob_ = v0; *(u32x4*)(ob_ + 16) = v1; } \
        else { const LAS unsigned char* src = Os + (tid >> 3) * OP + (tid & 7) * 16; const u32x4 v0 = *(const LAS u32x4*)src; *(u32x4*)ob_ = v0; } } while (0)
    MIX_LOAD(0, 0);
    for (int n = 0; n < N; ++n) { constexpr int par = 0;
        if (IS_A) {
            float run0 = 0.f, run1 = 0.f;
#pragma unroll
            for (int i = 0; i < 8; ++i) { run0 += bf_lo(rf[par][i]); run1 += bf_hi(rf[par][i]); }
            *(LAS f32x2*)(seg + sg * DK + 2 * cp) = (f32x2){run0, run1};
        }
        LDS_BARRIER();
        if (n > 0) MIX_FLUSH(n - 1);
        {
            unsigned kt0[4], kt1[4], vt0[4], vt1[4];
            if (IS_A) {
                float pre0 = 0.f, pre1 = 0.f, ref0 = 0.f, ref1 = 0.f, tot0 = 0.f, tot1 = 0.f;
#pragma unroll
                for (int s8 = 0; s8 < 8; ++s8) { const f32x2 v = *(const LAS f32x2*)(seg + s8 * DK + 2 * cp);
                    if (s8 < sg) { pre0 += v.x; pre1 += v.y; } if (s8 < 4) { ref0 += v.x; ref1 += v.y; } tot0 += v.x; tot1 += v.y; }
                f32x2 E = (f32x2){exp2_(fminf(fmaxf(pre0 - ref0, -115.f), 115.f)), exp2_(fminf(fmaxf(pre1 - ref1, -115.f), 115.f))};
#pragma unroll
                for (int ip = 0; ip < 4; ++ip) { unsigned kp[2];
#pragma unroll
                    for (int e = 0; e < 2; ++e) { const int i = 2 * ip + e;
                        const f32x2 f = (f32x2){exp2_(bf_lo(rf[par][i])), exp2_(bf_hi(rf[par][i]))};
                        E = __builtin_elementwise_max(E * f, (f32x2){1e-35f, 1e-35f});
                        const f32x2 r = (f32x2){rcp_(E.x), rcp_(E.y)};
                        const f32x2 k = r - f * r;
                        const f32x2 qv = (f32x2){bf_lo(rq[par][i]), bf_hi(rq[par][i])} * E;
                        const int t = sg * 8 + i;
                        const int cb4 = (4 * cp) ^ ((i >= 4 ? 16 : 0) ^ sgx);
                        *(LAS unsigned*)(Qs + t * QP + cb4) = cvt_pk_bf16(qv.x, qv.y);
                        kp[e] = cvt_pk_bf16(k.x, k.y);
                        *(LAS unsigned*)(Ks + t * QP + cb4) = kp[e]; }
                    kt0[ip] = __builtin_amdgcn_perm(kp[1], kp[0], 0x05040100u); kt1[ip] = __builtin_amdgcn_perm(kp[1], kp[0], 0x07060302u);
                    vt0[ip] = __builtin_amdgcn_perm(rv[par][2 * ip + 1], rv[par][2 * ip], 0x05040100u); vt1[ip] = __builtin_amdgcn_perm(rv[par][2 * ip + 1], rv[par][2 * ip], 0x07060302u);
                }
                if (sg == 0) { *(LAS f32x2*)(cdec + 2 * cp) = (f32x2){exp2_(fmaxf(tot0, -115.f)), exp2_(fmaxf(tot1, -115.f))};
                               *(LAS f32x2*)(csc + 2 * cp) = (f32x2){exp2_(fmaxf(tot0 - ref0, -115.f)), exp2_(fmaxf(tot1 - ref1, -115.f))}; }
                *(LAS u32x4*)(Kt + (2 * cp) * TP + ((sg * 16) ^ (gk << 4))) = (u32x4){kt0[0], kt0[1], kt0[2], kt0[3]};
                *(LAS u32x4*)(Kt + (2 * cp + 1) * TP + ((sg * 16) ^ (gk << 4))) = (u32x4){kt1[0], kt1[1], kt1[2], kt1[3]};
            } else {
                const int ci = cp & 31;
#pragma unroll
                for (int ip = 0; ip < 4; ++ip) { unsigned kp[2];
#pragma unroll
                    for (int e = 0; e < 2; ++e) { const int i = 2 * ip + e; const int t = sg * 8 + i;
                        const float dd = (float)(t - 31) * lg;
                        const float sc = __expf(cp < 32 ? dd : -dd);
                        kp[e] = cvt_pk_bf16(bf_lo(rq[par][i]) * sc, bf_hi(rq[par][i]) * sc);
                        *(LAS unsigned*)((cp < 32 ? Qs : Ks) + t * QP + ((4 * ci) ^ ((i >= 4 ? 16 : 0) ^ sgx))) = kp[e]; }
                    kt0[ip] = __builtin_amdgcn_perm(kp[1], kp[0], 0x05040100u); kt1[ip] = __builtin_amdgcn_perm(kp[1], kp[0], 0x07060302u);
                    vt0[ip] = __builtin_amdgcn_perm(rv[par][2 * ip + 1], rv[par][2 * ip], 0x05040100u); vt1[ip] = __builtin_amdgcn_perm(rv[par][2 * ip + 1], rv[par][2 * ip], 0x07060302u);
                }
                if (cp >= 32) { *(LAS u32x4*)(Kt + (2 * ci) * TP + ((sg * 16) ^ (gk << 4))) = (u32x4){kt0[0], kt0[1], kt0[2], kt0[3]};
                                *(LAS u32x4*)(Kt + (2 * ci + 1) * TP + ((sg * 16) ^ (gk << 4))) = (u32x4){kt1[0], kt1[1], kt1[2], kt1[3]}; }
            }
            if (NDV == 8 || cp < 32) {
            *(LAS u32x4*)(Vt + (2 * cp) * TP + ((sg * 16) ^ (gk << 4))) = (u32x4){vt0[0], vt0[1], vt0[2], vt0[3]};
            *(LAS u32x4*)(Vt + (2 * cp + 1) * TP + ((sg * 16) ^ (gk << 4))) = (u32x4){vt1[0], vt1[1], vt1[2], vt1[3]}; }
        }
#pragma unroll
        for (int dki = 0; dki < 2; ++dki) { f32x4 er;
          if (IS_A) { const int dk = (tdk0 + dki) * 16 + fq * 4; const f32x4 e = *(const LAS f32x4*)(seg + dk) + *(const LAS f32x4*)(seg + DK + dk) + *(const LAS f32x4*)(seg + 2 * DK + dk) + *(const LAS f32x4*)(seg + 3 * DK + dk);
#pragma unroll
              for (int j = 0; j < 4; ++j) er[j] = exp2_(fmaxf(e[j], -115.f)); }
          else { const float e = __expf(32.0f * lg); er = (f32x4){e, e, e, e}; }
#pragma unroll
          for (int dvi = 0; dvi < DVW; ++dvi) { const f32x4 sv = S[dki * DVW + dvi] * er; u32x2 pk; pk.x = cvt_pk_bf16(sv[0], sv[1]); pk.y = cvt_pk_bf16(sv[2], sv[3]);
              *(LAS u32x2*)(St + ((tdv0 + dvi) * 16 + fr) * QP + ((((tdk0 + dki) * 16 + fq * 4) * 2) ^ (gx << 4))) = pk; } }
        if (n + 1 < N) MIX_LOAD(n + 1, par);
        LDS_BARRIER();
        { const int tt = w >> 1, ts0 = (w & 1) * 2; f32x4 pa = (f32x4){0.f, 0.f, 0.f, 0.f}, pb = pa;
          bf16x8 gq_[KS], gk0[KS], gk1[KS];
#pragma unroll
          for (int ks = 0; ks < KS; ++ks) { gq_[ks] = ldfrag(Qs, QP, tt, ks, fr, fqx); gk0[ks] = ldfrag(Ks, QP, ts0, ks, fr, fqx); gk1[ks] = ldfrag(Ks, QP, ts0 + 1, ks, fr, fqx); }
          __builtin_amdgcn_sched_barrier(0);
#pragma unroll
          for (int ks = 0; ks < KS; ++ks) { pa = MFMA16(gk0[ks], gq_[ks], pa); pb = MFMA16(gk1[ks], gq_[ks], pb); }
          const int t = tt * 16 + fr, s0 = ts0 * 16 + fq * 4, s1 = s0 + 16;
          u32x2 w0, w1;
          w0.x = cvt_pk_bf16(t >= s0 ? pa[0] : 0.f, t >= s0 + 1 ? pa[1] : 0.f); w0.y = cvt_pk_bf16(t >= s0 + 2 ? pa[2] : 0.f, t >= s0 + 3 ? pa[3] : 0.f);
          w1.x = cvt_pk_bf16(t >= s1 ? pb[0] : 0.f, t >= s1 + 1 ? pb[1] : 0.f); w1.y = cvt_pk_bf16(t >= s1 + 2 ? pb[2] : 0.f, t >= s1 + 3 ? pb[3] : 0.f);
          *(LAS u32x2*)(Ps + t * TP + ((s0 * 2) ^ (gx << 4))) = w0; *(LAS u32x2*)(Ps + t * TP + ((s1 * 2) ^ (gx << 4))) = w1; }
#pragma unroll
        for (int ks = 0; ks < 2; ++ks) { bf16x8 ak[2], bv[DVW];
#pragma unroll
            for (int dki = 0; dki < 2; ++dki) ak[dki] = ldfrag(Kt, TP, tdk0 + dki, ks, fr, fqx);
#pragma unroll
            for (int dvi = 0; dvi < DVW; ++dvi) bv[dvi] = ldfrag(Vt, TP, tdv0 + dvi, ks, fr, fqx);
            __builtin_amdgcn_sched_barrier(0);
#pragma unroll
            for (int dki = 0; dki < 2; ++dki)
#pragma unroll
                for (int dvi = 0; dvi < DVW; ++dvi) U[dki * DVW + dvi] = MFMA16(ak[dki], bv[dvi], U[dki * DVW + dvi]);
            __builtin_amdgcn_sched_barrier(0); }
        LDS_BARRIER();
        { const int tp = w >> 2, dp = w & 3; f32x4 o[4];
#pragma unroll
          for (int q = 0; q < 4; ++q) o[q] = (f32x4){0.f, 0.f, 0.f, 0.f};
#pragma unroll
          for (int kb = 0; kb < KS; kb += 2) { bf16x8 b[2][2], a[2][2];
#pragma unroll
              for (int k2 = 0; k2 < 2; ++k2)
#pragma unroll
                  for (int i2 = 0; i2 < 2; ++i2) { b[k2][i2] = ldfrag(Qs, QP, 2 * tp + i2, kb + k2, fr, fqx); a[k2][i2] = ldfrag(St, QP, 2 * dp + i2, kb + k2, fr, fqx); }
              __builtin_amdgcn_sched_barrier(0);
#pragma unroll
              for (int k2 = 0; k2 < 2; ++k2)
#pragma unroll
                  for (int ti = 0; ti < 2; ++ti)
#pragma unroll
                      for (int di = 0; di < 2; ++di) o[ti * 2 + di] = MFMA16(a[k2][di], b[k2][ti], o[ti * 2 + di]);
              __builtin_amdgcn_sched_barrier(0); }
          { bf16x8 b[2][2], a[2][2];
#pragma unroll
              for (int k2 = 0; k2 < 2; ++k2)
#pragma unroll
                  for (int i2 = 0; i2 < 2; ++i2) { b[k2][i2] = ldfrag(Ps, TP, 2 * tp + i2, k2, fr, fqx); a[k2][i2] = ldfrag(Vt, TP, 2 * dp + i2, k2, fr, fqx); }
              __builtin_amdgcn_sched_barrier(0);
#pragma unroll
              for (int k2 = 0; k2 < 2; ++k2)
#pragma unroll
                  for (int ti = 0; ti < 2; ++ti)
#pragma unroll
                      for (int di = 0; di < 2; ++di) o[ti * 2 + di] = MFMA16(a[k2][di], b[k2][ti], o[ti * 2 + di]);
              __builtin_amdgcn_sched_barrier(0); }
#pragma unroll
          for (int ti = 0; ti < 2; ++ti)
#pragma unroll
              for (int di = 0; di < 2; ++di) { const f32x4 ov = o[ti * 2 + di]; u32x2 pk; pk.x = cvt_pk_bf16(ov[0], ov[1]); pk.y = cvt_pk_bf16(ov[2], ov[3]);
                  *(LAS u32x2*)(Os + ((2 * tp + ti) * 16 + fr) * OP + ((2 * dp + di) * 16 + fq * 4) * 2) = pk; } }
#pragma unroll
        for (int dki = 0; dki < 2; ++dki) { f32x4 cd, cs;
          if (IS_A) { cd = *(const LAS f32x4*)(cdec + (tdk0 + dki) * 16 + fq * 4); cs = *(const LAS f32x4*)(csc + (tdk0 + dki) * 16 + fq * 4); }
          else { const float a = __expf(64.0f * lg), b = __expf(32.0f * lg); cd = (f32x4){a, a, a, a}; cs = (f32x4){b, b, b, b}; }
#pragma unroll
          for (int dvi = 0; dvi < DVW; ++dvi) { S[dki * DVW + dvi] = S[dki * DVW + dvi] * cd + U[dki * DVW + dvi] * cs; U[dki * DVW + dvi] = (f32x4){0.f, 0.f, 0.f, 0.f}; } }
    }
    __syncthreads();
    MIX_FLUSH(N - 1);
    __syncthreads();
#undef MIX_LOAD
#undef MIX_FLUSH
#undef MIX_RB
}

__device__ __forceinline__ void phase_mix(const Params& p, LAS unsigned char* lds, int l, int g) {
    const int G = gridDim.x, b = blockIdx.x;
    const int nstreams = g == 0 ? 256 : 320;
    for (int r = 0; r * G < nstreams; ++r) {
        const int bi = (r & 1) ? (G - 1 - b) : b; const int sidx = r * G + bi;
        if (sidx >= nstreams) continue;
        bool isA; int q, rs, T;
        if (g == 0) {
            if (sidx < 64) { isA = sidx < 32; q = sidx & 31; rs = (q >> 4) * 8192; T = 8192; }
            else { isA = sidx < 160; q = isA ? sidx - 64 : sidx - 160; rs = 16384 + (q >> 4) * 4096; T = 4096; }
        } else { isA = sidx < 160; q = isA ? sidx : sidx - 160; rs = (q >> 4) * 4096; T = 4096; }
        const int h = (q >> 1) & 7, dir = q & 1;
        if (isA) mix_stream<128, true, 8>(p, lds, l, rs, T, h, dir, 0); else mix_stream<64, false, 8>(p, lds, l, rs, T, h, dir, 0);
    }
}

constexpr int N_PHASES = 3 + 6 * 4;
constexpr int LDS_BYTES = MIX_LDS_MAX + 16;

__global__ void __launch_bounds__(512, 2) fwd_megakernel(Params p) {
    extern __shared__ __attribute__((aligned(16))) unsigned char lds_raw[];
    LAS unsigned char* lds = (LAS unsigned char*)lds_raw;
    cg::grid_group grid = cg::this_grid();
    if (threadIdx.x < 4) ((LAS unsigned*)(lds + MIX_LDS_MAX))[threadIdx.x] = 0u;
    __syncthreads();
    XcdBarrier xbar = xcd_barrier_post((unsigned*)(p.ws + WS_BAR), (volatile LAS unsigned*)(lds + MIX_LDS_MAX));
    const int G = gridDim.x, bid = blockIdx.x;
    bf16_t* proj = (bf16_t*)(p.ws + WS_PROJ); bf16_t* ubuf = (bf16_t*)(p.ws + WS_U);
    for (int ph = p.ph_lo; ph < p.ph_hi; ++ph) {
        if (ph == 0) phase_init(p, lds);
        else if (ph == 1) phase_ada_fin(p);
        else if (ph == 2) phase_prep(p, 0, 0);
        else {
            const int idx = (ph - 3) / 6, sub = (ph - 3) % 6, g = idx >> 1, l = idx & 1;
            const bool ovl = (G == 256) && (g == 0);
            bool extra = false;
            if (sub == 1) {
                phase_mix(p, lds, l, g);
                if (ovl && bid >= 64) {
                    unsigned* sb = (unsigned*)(p.ws + WS_BAR) + 3520 + l * 128;
                    subset_barrier(sb, 192u);
                    phase_comb(p, l, 16384, MG - 16384, 192, bid - 64);
                    subset_barrier(sb + 64, 192u);
                    extra = true;
                }
            }
            else if (sub == 2) { if (ovl) phase_comb(p, l, 0, 16384, G, bid); else phase_comb(p, l, 0, MG, G, bid); }
            if (sub == 0 || sub == 3 || sub == 4 || extra) {
                pg8::Gemm gm; EpiAll E; pg8::StaticOrder S;
                E.lbp = p.hgrn_lb; E.rope = (const float2*)(p.ws + WS_ROPE); E.proj = proj; E.xp = p.x_prompt; E.xs = p.x_sample; E.out = p.out; E.g = g; E.layer = l;
                if (sub == 0)      { gm = pg8::Gemm{ubuf, (const bf16_t*)(p.ws + WS_WT1) + (size_t)l * 10240 * 1024, MG, NC1, 1024, 1024, 1024, nullptr, nullptr}; E.mode = 0; E.O = proj; E.bias = p.b_mg + l * 2048; S.init(MG, NC1, G, bid); }
                else if (sub == 4) { gm = pg8::Gemm{ubuf, (const bf16_t*)(p.ws + WS_WOUT) + (size_t)l * 1024 * 1024, MG, 1024, 1024, 1024, 1024, nullptr, nullptr}; E.mode = 3; E.O = ubuf; E.bias = (const float*)(p.ws + WS_ADA) + l * 18 * 3072; S.init(MG, 1024, G, bid); }
                else { gm = pg8::Gemm{proj + C_AG, (const bf16_t*)(p.ws + WS_WPA) + (size_t)l * 1024 * 1024, MG, 1024, 1024, NC1, 1024, proj + C_RG, (const bf16_t*)(p.ws + WS_WPB) + (size_t)l * 1024 * 1024}; E.mode = 1; E.O = ubuf; E.bias = nullptr;
                    if (extra) S.init(MG - 16384, 1024, 192, bid - 64, 64); else if (ovl) S.init(16384, 1024, G, bid); else S.init(MG, 1024, G, bid); }
                pg8::gemm_phase<EpiAll>(lds, gm, S, E);
            }
            if (sub == 5) {
                phase_ln(p, l, g, l == 0);
                if (l == 1 && g == 0) phase_prep(p, 0, 1);
            }
        }
        if (ph + 1 < p.ph_hi) { if (ph == 0) grid.sync(); else xcd_barrier(xbar); }
    }
}

#ifndef ONE_LAUNCH
#define ONE_LAUNCH 1
#endif
extern "C" void kernel_launch(void* const* d_in, const int* in_sizes, int n_in, void* d_out, int out_size, void* d_ws, size_t ws_size, hipStream_t stream) {
    static int grid = 0;
    if (grid == 0) {
        if (n_in != 17 || out_size != NTOK * D || ws_size < WS_END) { fprintf(stderr, "kernel_launch: unexpected shapes / workspace (n_in %d out %d ws %zu need %zu)\n", n_in, out_size, ws_size, (size_t)WS_END); grid = -1; return; }
        int dev = 0, cus = 0, per_cu = 0;
        hipGetDevice(&dev); hipDeviceGetAttribute(&cus, hipDeviceAttributeMultiprocessorCount, dev);
        if (hipFuncSetAttribute((const void*)fwd_megakernel, hipFuncAttributeMaxDynamicSharedMemorySize, LDS_BYTES) != hipSuccess) { fprintf(stderr, "kernel_launch: hipFuncSetAttribute failed\n"); grid = -1; return; }
        if (hipOccupancyMaxActiveBlocksPerMultiprocessor(&per_cu, (const void*)fwd_megakernel, 512, LDS_BYTES) != hipSuccess || per_cu < 1) { fprintf(stderr, "kernel_launch: occupancy query says %d\n", per_cu); per_cu = 1; }
        (void)hipGetLastError();
        grid = cus;
    }
    if (grid < 0) return;
    if (hipMemsetAsync((char*)d_ws + WS_BAR, 0, 16384, stream) != hipSuccess) { fprintf(stderr, "kernel_launch: memset of the barrier words failed\n"); return; }
    Params p{};
    p.x_prompt = (const float*)d_in[0]; p.x_sample = (const float*)d_in[1]; p.c_prompt = (const float*)d_in[2]; p.c_sample = (const float*)d_in[3];
    p.w_ada = (const float*)d_in[4]; p.b_ada = (const float*)d_in[5]; p.w_in = (const float*)d_in[6]; p.hgrn_lb = (const float*)d_in[7]; p.a_norm_w = (const float*)d_in[8];
    p.ret_decay = (const float*)d_in[9]; p.w_pa = (const float*)d_in[10]; p.w_pb = (const float*)d_in[11]; p.w_mg = (const float*)d_in[12]; p.b_mg = (const float*)d_in[13];
    p.w_out = (const float*)d_in[14]; p.ln_g = (const float*)d_in[15]; p.ln_b = (const float*)d_in[16];
    p.out = (float*)d_out; p.ws = (unsigned char*)d_ws;
#if ONE_LAUNCH
    p.ph_lo = 0; p.ph_hi = N_PHASES;
    void* args[] = {&p};
    hipError_t e = hipLaunchCooperativeKernel((const void*)fwd_megakernel, dim3(grid), dim3(512), args, LDS_BYTES, stream);
    if (e != hipSuccess) fprintf(stderr, "cooperative launch failed: %s (grid %d)\n", hipGetErrorString(e), grid);
#else
    for (int ph = 0; ph < N_PHASES; ++ph) { p.ph_lo = ph; p.ph_hi = ph + 1; hipLaunchKernelGGL(fwd_megakernel, dim3(grid), dim3(512), LDS_BYTES, stream, p); }
#endif
}
```
